# Optimizing an MI355X kernel written in HIP

```python
import jax, jax.numpy as jnp
from jax import lax
import numpy as np

D_MODEL = 2048
BATCH = 4
SEQ = 4096
DEPTH = 1

MIX_WIDTH = D_MODEL
FOURIER_WIDTH = MIX_WIDTH // 2
N_FOURIER_GROUPS = 4
FOURIER_GROUP_DIM = FOURIER_WIDTH // N_FOURIER_GROUPS
ATTN_WIDTH = MIX_WIDTH - FOURIER_WIDTH
HEAD_DIM = 128
N_HEADS = ATTN_WIDTH // HEAD_DIM
WINDOW_DILATIONS = ((128, 1), (512, 4), (2048, 16))
D_FF = 4 * D_MODEL
IN_WIDTH = FOURIER_WIDTH + 3 * ATTN_WIDTH
RMS_EPS = 1e-6

kernel_name = "hybrid_fourier_dilated_alibi_block"


def _rmsnorm(x, g):
    xf = x.astype(jnp.float32)
    inv = lax.rsqrt(jnp.mean(xf * xf, axis=-1, keepdims=True) + RMS_EPS)
    return (xf * inv * g.astype(jnp.float32)).astype(x.dtype)


def _alibi_slopes(n_heads):
    return jnp.asarray(2.0 ** (-8.0 * (np.arange(n_heads) + 1) / n_heads), dtype=jnp.float32)


def _dilated_branch(q, k, v, slopes, dilation, radius):
    B, H, S, Dh = q.shape
    M = S // dilation
    blk = radius
    nb = -(-M // blk)
    Mp = nb * blk

    def to_classes(t):
        return t.reshape(B, H, M, dilation, Dh).transpose(0, 1, 3, 2, 4)

    pad0 = ((0, 0), (0, 0), (0, 0))
    qc = jnp.pad(to_classes(q), pad0 + ((0, Mp - M), (0, 0))).reshape(B, H, dilation, nb, blk, Dh)
    kc = jnp.pad(to_classes(k), pad0 + ((blk, Mp - M + blk), (0, 0))).reshape(B, H, dilation, nb + 2, blk, Dh)
    vc = jnp.pad(to_classes(v), pad0 + ((blk, Mp - M + blk), (0, 0))).reshape(B, H, dilation, nb + 2, blk, Dh)
    kw = jnp.concatenate([kc[:, :, :, :-2], kc[:, :, :, 1:-1], kc[:, :, :, 2:]], axis=4)
    vw = jnp.concatenate([vc[:, :, :, :-2], vc[:, :, :, 1:-1], vc[:, :, :, 2:]], axis=4)

    mq = jnp.arange(nb)[:, None, None] * blk + jnp.arange(blk)[None, :, None]
    mk = jnp.arange(nb)[:, None, None] * blk - blk + jnp.arange(3 * blk)[None, None, :]
    rel = mk - mq
    valid = (jnp.abs(rel) <= radius) & (mk >= 0) & (mk < M)
    dist = (dilation * jnp.abs(rel)).astype(jnp.float32)

    s = jnp.einsum('bhrnqd,bhrnkd->bhrnqk', qc, kw).astype(jnp.float32)
    s = s - slopes[None, :, None, None, None, None] * dist
    s = jnp.where(valid, s, -jnp.inf)
    mx = jnp.max(s, axis=-1, keepdims=True)
    p = jnp.exp(s - mx)
    den = jnp.sum(p, axis=-1)
    o = jnp.einsum('bhrnqk,bhrnkd->bhrnqd', p.astype(v.dtype), vw).astype(jnp.float32) / den[..., None]

    def from_classes(t):
        tail = t.shape[5:]
        t = t.reshape((B, H, dilation, Mp) + tail)[:, :, :, :M]
        t = jnp.moveaxis(t, 2, 3)
        return t.reshape((B, H, S) + tail)

    return from_classes(o), from_classes(mx[..., 0]), from_classes(den)


def _dilated_attention(q, k, v):
    slopes = _alibi_slopes(q.shape[1])
    outs, maxes, dens = [], [], []
    for window, dil in WINDOW_DILATIONS:
        o, m, d = _dilated_branch(q, k, v, slopes, dil, (window // 2) // dil)
        outs.append(o); maxes.append(m); dens.append(d)
    mx = jnp.stack(maxes)
    w = jnp.stack(dens) * jnp.exp(mx - jnp.max(mx, axis=0, keepdims=True))
    o = jnp.sum(w[..., None] * jnp.stack(outs), axis=0) / jnp.sum(w, axis=0)[..., None]
    return o


def _fourier_mix(u, w_f):
    B, S, _ = u.shape
    ug = u.reshape(B, S, N_FOURIER_GROUPS, FOURIER_GROUP_DIM).astype(jnp.float32)
    re = jnp.fft.fft2(ug, axes=(1, 3), norm="ortho").real.astype(u.dtype)
    y = jnp.einsum('bsgc,gce->bsge', re, w_f)
    return y.reshape(B, S, FOURIER_WIDTH)


def setup_inputs(seed: int = 0) -> dict:
    key = jax.random.key(seed)
    ks = jax.random.split(key, 10)
    f32 = jnp.float32
    x = jax.random.normal(ks[0], (BATCH, SEQ, D_MODEL), f32)
    norm_mix_g = 1.0 + 0.02 * jax.random.normal(ks[1], (DEPTH, D_MODEL), f32)
    w_in = jax.random.normal(ks[2], (DEPTH, D_MODEL, IN_WIDTH), f32) * D_MODEL ** -0.5
    w_fourier = jax.random.normal(ks[3], (DEPTH, N_FOURIER_GROUPS, FOURIER_GROUP_DIM, FOURIER_GROUP_DIM), f32) * FOURIER_GROUP_DIM ** -0.5
    w_out = jax.random.normal(ks[4], (DEPTH, MIX_WIDTH, D_MODEL), f32) * MIX_WIDTH ** -0.5
    norm_mlp_g = 1.0 + 0.02 * jax.random.normal(ks[5], (DEPTH, D_MODEL), f32)
    w_up = jax.random.normal(ks[6], (DEPTH, D_MODEL, D_FF), f32) * D_MODEL ** -0.5
    w_down = jax.random.normal(ks[7], (DEPTH, D_FF, D_MODEL), f32) * D_FF ** -0.5
    norm_final_g = 1.0 + 0.02 * jax.random.normal(ks[8], (D_MODEL,), f32)
    return {"x": x, "norm_mix_g": norm_mix_g, "w_in": w_in, "w_fourier": w_fourier,
            "w_out": w_out, "norm_mlp_g": norm_mlp_g, "w_up": w_up, "w_down": w_down,
            "norm_final_g": norm_final_g}


def reference(x, norm_mix_g, w_in, w_fourier, w_out, norm_mlp_g, w_up, w_down, norm_final_g):
    B, S, _ = x.shape
    h = x
    for layer in range(DEPTH):
        u = _rmsnorm(h, norm_mix_g[layer])
        proj = jnp.einsum('bsd,de->bse', u, w_in[layer])
        u_f = proj[..., :FOURIER_WIDTH]
        qkv = proj[..., FOURIER_WIDTH:].reshape(B, S, 3, N_HEADS, HEAD_DIM)
        q = jnp.transpose(qkv[:, :, 0], (0, 2, 1, 3)) * (HEAD_DIM ** -0.5)
        k = jnp.transpose(qkv[:, :, 1], (0, 2, 1, 3))
        v = jnp.transpose(qkv[:, :, 2], (0, 2, 1, 3))
        y_f = _fourier_mix(u_f, w_fourier[layer])
        y_a = _dilated_attention(q, k, v).astype(h.dtype)
        y_a = jnp.transpose(y_a, (0, 2, 1, 3)).reshape(B, S, ATTN_WIDTH)
        y = jnp.concatenate([y_f, y_a], axis=-1)
        h = h + jnp.einsum('bse,ed->bsd', y, w_out[layer])
        u = _rmsnorm(h, norm_mlp_g[layer])
        a = jnp.einsum('bsd,df->bsf', u, w_up[layer])
        a = jnp.square(jax.nn.relu(a))
        h = h + jnp.einsum('bsf,fd->bsd', a, w_down[layer])
    return _rmsnorm(h, norm_final_g)
```

```cpp
#include <hip/hip_runtime.h>
#include <cstdio>
#include <cstdint>

constexpr int NB = 4, SEQ = 4096, DM = 2048, T = NB * SEQ, DFF = 8192;
constexpr int NH = 8;
constexpr float EPS = 1e-6f;
constexpr float LOG2E = 1.4426950408889634f;
constexpr float QSCALE = 0.08838834764831845f * LOG2E;

namespace pg8 {
#define PG8_LAS __attribute__((address_space(3)))
#define PG8_GAS __attribute__((address_space(1)))
__device__ __forceinline__ unsigned lane_id_fresh() { unsigned m = ~0u; asm volatile("" : "+s"(m)); return __builtin_amdgcn_mbcnt_hi(m, __builtin_amdgcn_mbcnt_lo(m, 0u)); }
typedef unsigned short bf16_t;
typedef short bf16x8 __attribute__((ext_vector_type(8)));
typedef float f32x4 __attribute__((ext_vector_type(4)));
typedef unsigned u32x4 __attribute__((ext_vector_type(4)));
typedef unsigned u32x2 __attribute__((ext_vector_type(2)));
constexpr int BM = 256, BK = 64, HALF = 128, HTB = HALF * BK * 2  , STAGE_BYTES = 8 * HTB, NXCD = 8, WGM = 4;

__host__ __device__ __forceinline__ int lds_byte(int r, int c) { const int st = (r >> 4) * 2 + (c >> 5), rr = r & 15, cc = c & 31, ob = rr * 64 + cc * 2; return st * 1024 + (ob ^ (((ob >> 9) & 1) << 5)); }
__host__ __device__ __forceinline__ void stage_rc(int b, int& R, int& C) { const int st = b / 1024, sb = b % 1024, swz = sb ^ (((sb >> 9) & 1) << 5); R = (st >> 1) * 16 + swz / 64; C = (st & 1) * 32 + (swz % 64) / 2; }
__host__ __device__ __forceinline__ int perm32(int rho) { const int n = rho >> 4, i = rho & 15; return 8 * (i >> 2) + 4 * n + (i & 3); }

struct Unit { int pm, pn; };
struct AddrStd {
    const bf16_t* A; const bf16_t* Bt; int lda, ldb, gshift; unsigned goff;
    __device__ __forceinline__ unsigned voffA(int R, int C) const { return (unsigned)(R * lda + C) * 2u; }
    __device__ __forceinline__ unsigned voffB(int R, int C) const { return (unsigned)(R * ldb + C) * 2u; }
    __device__ __forceinline__ size_t hA() const { return (size_t)HALF * lda * 2; }
    __device__ __forceinline__ size_t hB() const { return (size_t)HALF * ldb * 2; }
    __device__ __forceinline__ const char* a(const Unit& u) const { return (const char*)A + (size_t)u.pm * 2 * hA(); }
    __device__ __forceinline__ const char* b(const Unit& u) const { return (const char*)Bt + (size_t)u.pn * 2 * hB() + (size_t)(u.pm >> gshift) * goff; }
};
struct AddrF1u {
    const bf16_t* A; const bf16_t* Bt;
    __device__ __forceinline__ unsigned voffA(int R, int C) const { return (unsigned)(R * 256 + C) * 2u; }
    __device__ __forceinline__ unsigned voffB(int R, int C) const { return (unsigned)((256 * (R & 15) + (R >> 4)) * 1024 + C) * 2u; }
    __device__ __forceinline__ size_t hA() const { return (size_t)HALF * 256 * 2; }
    __device__ __forceinline__ size_t hB() const { return (size_t)8 * 1024 * 2; }
    __device__ __forceinline__ const char* a(const Unit& u) const { return (const char*)A + (size_t)u.pm * 2 * hA(); }
    __device__ __forceinline__ const char* b(const Unit& u) const { return (const char*)Bt + (size_t)((u.pn >> 4) * 4096 + (u.pn & 15) * 16) * 1024 * 2 + (size_t)(u.pm >> 1) * 512; }
};
struct AddrF2 {
    const bf16_t* A; const bf16_t* Bt;
    __device__ __forceinline__ unsigned voffA(int R, int C) const { return (unsigned)(R * 512 + C) * 2u; }
    __device__ __forceinline__ unsigned voffB(int R, int C) const { return (unsigned)(R * 8192 + C) * 2u; }
    __device__ __forceinline__ size_t hA() const { return (size_t)HALF * 512 * 2; }
    __device__ __forceinline__ size_t hB() const { return (size_t)HALF * 8192 * 2; }
    __device__ __forceinline__ const char* a(const Unit&) const { return (const char*)A; }
    __device__ __forceinline__ const char* b(const Unit& u) const { return (const char*)Bt + ((size_t)(((u.pm >> 4) * 1024 + u.pn * 256) * 16 + (u.pm & 15)) * 512) * 2; }
};

struct StaticOrder {
    int nM, nN, nwg, G, c, wgm;
    __host__ __device__ void init(int M, int N, int G_, int c_, int wgm_ = WGM) { nM = M / BM; nN = N / BM; nwg = nM * nN; G = G_; c = c_; wgm = wgm_; }
    __host__ __device__ bool next(int i, Unit& u) const {
        const long L = (long)i * G + c; if (L >= nwg) return false;
        int wgid = (int)L; { const int q = nwg / NXCD, r = nwg % NXCD, xcd = wgid % NXCD, off = wgid / NXCD; wgid = (xcd < r ? xcd * (q + 1) : r * (q + 1) + (xcd - r) * q) + off; }
        const int nig = wgm * nN, gid = wgid / nig, fm = gid * wgm, gsz = (nM - fm) < wgm ? (nM - fm) : wgm;
        u.pm = fm + ((wgid % nig) % gsz); u.pn = (wgid % nig) / gsz; return true;
    }
    __device__ __forceinline__ void a_ready(const Unit&) const {}
    __device__ __forceinline__ void done(const Unit&) const {}
};

__device__ __forceinline__ unsigned cvt_pk_bf16(float lo, float hi) { unsigned r; asm volatile("v_cvt_pk_bf16_f32 %0, %1, %2" : "=v"(r) : "v"(lo), "v"(hi)); return r; }

__device__ __forceinline__ unsigned pk_fp8x4(const f32x4 v) { int r = __builtin_amdgcn_cvt_pk_fp8_f32(v[0], v[1], 0, false); r = __builtin_amdgcn_cvt_pk_fp8_f32(v[2], v[3], r, true); return (unsigned)r; }
template <int ACT, int RS, bool CS, bool HM = false> struct EpiB {
    static constexpr bool PERM = true, AFTER_DRAIN = false;
    bf16_t* O; int ldc; const float* rs; const float* cs; int split_cols; size_t split_stride; float scale0;
    __device__ __forceinline__ void operator()(const f32x4 (&acc)[2][2][4][2], const Unit& u, int wr, int wc, int fr, int fq) const {
        { int l_ = (int)lane_id_fresh(); asm volatile("" : "+v"(l_)); fr = l_ & 15; fq = l_ >> 4; }
        const int row0 = u.pm * BM + wr * 64 + fr; int colt = u.pn * BM; bf16_t* base = O;
        float sc = 1.f; bool hm = false, k8 = false; if (split_cols) { const int t = colt / split_cols; base += (size_t)t * split_stride; colt -= t * split_cols; if (t == 0) sc = scale0; hm = HM && t < 3; k8 = HM && (t == 1 || t == 2); }
        const int col0 = colt + wc * 32 + 8 * fq, gcol0 = u.pn * BM + wc * 32 + 8 * fq;
        const size_t bstep = hm ? (size_t)4096 * 128 : (size_t)HALF;
        f32x4 cv[2][2];
#pragma unroll
        for (int bj = 0; bj < 2; ++bj)
#pragma unroll
            for (int n = 0; n < 2; ++n) cv[bj][n] = CS ? *(const f32x4*)(cs + gcol0 + bj * HALF + 4 * n) : (f32x4){1.f, 1.f, 1.f, 1.f};
        float rsv[2][4];
#pragma unroll
        for (int ai = 0; ai < 2; ++ai)
#pragma unroll
            for (int m = 0; m < 4; ++m) rsv[ai][m] = RS ? rs[row0 + ai * HALF + m * 16] : 1.0f;
#pragma unroll
        for (int ai = 0; ai < 2; ++ai)
#pragma unroll
            for (int m = 0; m < 4; ++m) { const int r = row0 + ai * HALF + m * 16;
                bf16_t* rowp = hm ? base + ((size_t)((r >> 12) * 8 + (colt >> 7)) * 4096 + (r & 4095)) * 128 + wc * 32 + 8 * fq : base + (size_t)r * ldc + col0;
                float rv = sc; if (RS == 1) rv *= rsv[ai][m]; if (RS == 2) rv *= 1.0f / sqrtf(rsv[ai][m] * (1.0f / DM) + EPS);
#pragma unroll
                for (int bj = 0; bj < 2; ++bj) { f32x4 v0 = acc[ai][bj][m][0] * rv, v1 = acc[ai][bj][m][1] * rv;
                    if (CS) { v0 = v0 * cv[bj][0]; v1 = v1 * cv[bj][1]; }
                    if (ACT == 2) {
#pragma unroll
                        for (int e = 0; e < 4; ++e) { float a = v0[e] > 0.f ? v0[e] : 0.f, b = v1[e] > 0.f ? v1[e] : 0.f; v0[e] = a * a; v1[e] = b * b; } }
                    if (k8) {
                        u32x2 w8; w8.x = pk_fp8x4(v0); w8.y = pk_fp8x4(v1);
                        *(u32x2*)((unsigned char*)base + ((size_t)((r >> 12) * 8 + (colt >> 7) + bj) * 4096 + (r & 4095)) * 128 + wc * 32 + 8 * fq) = w8;
                    } else {
                    u32x4 w; w.x = cvt_pk_bf16(v0[0], v0[1]); w.y = cvt_pk_bf16(v0[2], v0[3]); w.z = cvt_pk_bf16(v1[0], v1[1]); w.w = cvt_pk_bf16(v1[2], v1[3]);
                    *(u32x4*)(rowp + bj * bstep) = w; } } }
    }
};
struct EpiResXb {
    static constexpr bool PERM = true, AFTER_DRAIN = false;
    const bf16_t* xb; bf16_t* outb; float* ssq; int ldc; float asc;
    __device__ __forceinline__ void operator()(const f32x4 (&acc)[2][2][4][2], const Unit& u, int wr, int wc, int fr, int fq) const {
        { int l_ = (int)lane_id_fresh(); asm volatile("" : "+v"(l_)); fr = l_ & 15; fq = l_ >> 4; }
        const int row0 = u.pm * BM + wr * 64 + fr, col0 = u.pn * BM + wc * 32 + 8 * fq;
        u32x4 bv[2][4][2];
#pragma unroll
        for (int ai = 0; ai < 2; ++ai)
#pragma unroll
            for (int m = 0; m < 4; ++m) { const size_t off = (size_t)(row0 + ai * HALF + m * 16) * ldc + col0;
#pragma unroll
                for (int bj = 0; bj < 2; ++bj) bv[ai][m][bj] = __builtin_nontemporal_load((const u32x4*)(xb + off + bj * HALF)); }
#pragma unroll
        for (int ai = 0; ai < 2; ++ai)
#pragma unroll
            for (int m = 0; m < 4; ++m) { const int r = row0 + ai * HALF + m * 16; const size_t off = (size_t)r * ldc + col0; float s = 0.f;
#pragma unroll
                for (int bj = 0; bj < 2; ++bj) { const u32x4 b = bv[ai][m][bj];
                    f32x4 o0, o1;
                    o0[0] = __builtin_fmaf(acc[ai][bj][m][0][0], asc, __builtin_bit_cast(float, b.x << 16)); o0[1] = __builtin_fmaf(acc[ai][bj][m][0][1], asc, __builtin_bit_cast(float, b.x & 0xffff0000u));
                    o0[2] = __builtin_fmaf(acc[ai][bj][m][0][2], asc, __builtin_bit_cast(float, b.y << 16)); o0[3] = __builtin_fmaf(acc[ai][bj][m][0][3], asc, __builtin_bit_cast(float, b.y & 0xffff0000u));
                    o1[0] = __builtin_fmaf(acc[ai][bj][m][1][0], asc, __builtin_bit_cast(float, b.z << 16)); o1[1] = __builtin_fmaf(acc[ai][bj][m][1][1], asc, __builtin_bit_cast(float, b.z & 0xffff0000u));
                    o1[2] = __builtin_fmaf(acc[ai][bj][m][1][2], asc, __builtin_bit_cast(float, b.w << 16)); o1[3] = __builtin_fmaf(acc[ai][bj][m][1][3], asc, __builtin_bit_cast(float, b.w & 0xffff0000u));
                    s += ((o0[0] * o0[0] + o0[1] * o0[1]) + (o0[2] * o0[2] + o0[3] * o0[3])) + ((o1[0] * o1[0] + o1[1] * o1[1]) + (o1[2] * o1[2] + o1[3] * o1[3]));
                    u32x4 w; w.x = cvt_pk_bf16(o0[0], o0[1]); w.y = cvt_pk_bf16(o0[2], o0[3]); w.z = cvt_pk_bf16(o1[0], o1[1]); w.w = cvt_pk_bf16(o1[2], o1[3]);
                    *(u32x4*)(outb + off + bj * HALF) = w; }
                s += __shfl_xor(s, 16); s += __shfl_xor(s, 32);
                if (fq == 0) atomicAdd(ssq + r, s); }
    }
};
struct EpiResB {
    static constexpr bool PERM = true, AFTER_DRAIN = false;
    bf16_t* hb; float* ssq; int ldc;
    __device__ __forceinline__ void operator()(const f32x4 (&acc)[2][2][4][2], const Unit& u, int wr, int wc, int fr, int fq) const {
        { int l_ = (int)lane_id_fresh(); asm volatile("" : "+v"(l_)); fr = l_ & 15; fq = l_ >> 4; }
        const int row0 = u.pm * BM + wr * 64 + fr, col0 = u.pn * BM + wc * 32 + 8 * fq;
        u32x4 bv[2][4][2];
#pragma unroll
        for (int ai = 0; ai < 2; ++ai)
#pragma unroll
            for (int m = 0; m < 4; ++m) { const size_t off = (size_t)(row0 + ai * HALF + m * 16) * ldc + col0;
#pragma unroll
                for (int bj = 0; bj < 2; ++bj) bv[ai][m][bj] = *(const u32x4*)(hb + off + bj * HALF); }
#pragma unroll
        for (int ai = 0; ai < 2; ++ai)
#pragma unroll
            for (int m = 0; m < 4; ++m) { const int r = row0 + ai * HALF + m * 16; const size_t off = (size_t)r * ldc + col0; float s = 0.f;
#pragma unroll
                for (int bj = 0; bj < 2; ++bj) { const u32x4 b = bv[ai][m][bj];
                    f32x4 o0, o1;
                    o0[0] = __builtin_bit_cast(float, b.x << 16) + acc[ai][bj][m][0][0]; o0[1] = __builtin_bit_cast(float, b.x & 0xffff0000u) + acc[ai][bj][m][0][1];
                    o0[2] = __builtin_bit_cast(float, b.y << 16) + acc[ai][bj][m][0][2]; o0[3] = __builtin_bit_cast(float, b.y & 0xffff0000u) + acc[ai][bj][m][0][3];
                    o1[0] = __builtin_bit_cast(float, b.z << 16) + acc[ai][bj][m][1][0]; o1[1] = __builtin_bit_cast(float, b.z & 0xffff0000u) + acc[ai][bj][m][1][1];
                    o1[2] = __builtin_bit_cast(float, b.w << 16) + acc[ai][bj][m][1][2]; o1[3] = __builtin_bit_cast(float, b.w & 0xffff0000u) + acc[ai][bj][m][1][3];
                    s += ((o0[0] * o0[0] + o0[1] * o0[1]) + (o0[2] * o0[2] + o0[3] * o0[3])) + ((o1[0] * o1[0] + o1[1] * o1[1]) + (o1[2] * o1[2] + o1[3] * o1[3]));
                    u32x4 w; w.x = cvt_pk_bf16(o0[0], o0[1]); w.y = cvt_pk_bf16(o0[2], o0[3]); w.z = cvt_pk_bf16(o1[0], o1[1]); w.w = cvt_pk_bf16(o1[2], o1[3]);
                    *(u32x4*)(hb + off + bj * HALF) = w; }
                s += __shfl_xor(s, 16); s += __shfl_xor(s, 32);
                if (fq == 0) atomicAdd(ssq + r, s); }
    }
};
struct OneUnit {
    Unit u;
    __device__ __forceinline__ bool next(int i, Unit& o) const { if (i) return false; o = u; return true; }
    __device__ __forceinline__ void a_ready(const Unit&) const {}
    __device__ __forceinline__ void done(const Unit&) const {}
};
struct EpiDft1 {
    static constexpr bool PERM = true, AFTER_DRAIN = true;
    bf16_t* Tp; PG8_LAS unsigned char* lds;
    __device__ __forceinline__ void operator()(const f32x4 (&acc)[2][2][4][2], const Unit& u, int wr, int wc, int, int) const {
        int l_ = (int)lane_id_fresh(); asm volatile("" : "+v"(l_));
        const int fr = l_ & 15, fq = l_ >> 4;
        const int s1p = fr, kg = fq, part = kg >> 1, s1b = 8 * (kg & 1);
        bf16x8 bre, bim;
#pragma unroll
        for (int j = 0; j < 8; ++j) { const float ang = (float)(((s1b + j) * s1p) & 15) * (1.0f / 16.0f); const float c = __builtin_amdgcn_cosf(ang), sn = __builtin_amdgcn_sinf(ang);
            const float vre = part == 0 ? c : -sn, vim = part == 0 ? -sn : -c;
            bre[j] = (short)(cvt_pk_bf16(vre, 0.f) & 0xffffu); bim[j] = (short)(cvt_pk_bf16(vim, 0.f) & 0xffffu); }
        const int q = u.pn & 15, b = u.pn >> 4;
        float tc[4], ts[4];
#pragma unroll
        for (int i = 0; i < 4; ++i) { const float ang = (float)((q * 16 + 4 * kg + i) * s1p) * (1.0f / 4096.0f); tc[i] = __builtin_amdgcn_cosf(ang); ts[i] = __builtin_amdgcn_sinf(ang); }
        asm volatile("s_waitcnt vmcnt(0)" ::: "memory"); __builtin_amdgcn_s_barrier();
#pragma unroll
        for (int ai = 0; ai < 2; ++ai)
#pragma unroll
            for (int m = 0; m < 4; ++m) { const int R = ai * HALF + wr * 64 + m * 16 + fr;
#pragma unroll
                for (int bj = 0; bj < 2; ++bj) { const int c = 16 * bj + 4 * wc + fq, slot = ((c >> 1) + 16 * (c & 1)) ^ fr;
                    const f32x4 v0 = acc[ai][bj][m][0], v1 = acc[ai][bj][m][1];
                    u32x4 w; w.x = cvt_pk_bf16(v0[0], v0[1]); w.y = cvt_pk_bf16(v0[2], v0[3]); w.z = cvt_pk_bf16(v1[0], v1[1]); w.w = cvt_pk_bf16(v1[2], v1[3]);
                    *(PG8_LAS u32x4*)(lds + R * 512 + slot * 16) = w; } }
        asm volatile("s_waitcnt lgkmcnt(0)" ::: "memory"); __builtin_amdgcn_s_barrier();
        const int nl0 = (wr * 4 + wc) * 16;
        bf16_t* tout = Tp + (((size_t)b * 1024 + u.pm * 128 + nl0) * 16 + s1p) * 512 + q * 32 + 8 * kg;
        const int rdslot = s1p + 16 * (kg & 1);
#pragma unroll 4
        for (int j = 0; j < 16; ++j) { const int R = 2 * (nl0 + j) + part;
            const bf16x8 av = *(const PG8_LAS bf16x8*)(lds + R * 512 + ((rdslot ^ (R & 15)) * 16));
            const f32x4 z4 = {0.f, 0.f, 0.f, 0.f};
            const f32x4 cre = __builtin_amdgcn_mfma_f32_16x16x32_bf16(av, bre, z4, 0, 0, 0), cim = __builtin_amdgcn_mfma_f32_16x16x32_bf16(av, bim, z4, 0, 0, 0);
            u32x4 w;
            w.x = cvt_pk_bf16(cre[0] * tc[0] + cim[0] * ts[0], cim[0] * tc[0] - cre[0] * ts[0]); w.y = cvt_pk_bf16(cre[1] * tc[1] + cim[1] * ts[1], cim[1] * tc[1] - cre[1] * ts[1]);
            w.z = cvt_pk_bf16(cre[2] * tc[2] + cim[2] * ts[2], cim[2] * tc[2] - cre[2] * ts[2]); w.w = cvt_pk_bf16(cre[3] * tc[3] + cim[3] * ts[3], cim[3] * tc[3] - cre[3] * ts[3]);
            *(u32x4*)(tout + (size_t)j * 16 * 512) = w; }
    }
};
struct EpiResOut {
    static constexpr bool PERM = true, AFTER_DRAIN = false;
    const bf16_t* hb; float* ssq; float* out; const float* gf; unsigned* cnt; unsigned* tmo; int ldc; unsigned need;
    __device__ __forceinline__ void operator()(f32x4 (&acc)[2][2][4][2], const Unit& u, int wr, int wc, int fr, int fq) const {
        int l_ = (int)lane_id_fresh(); asm volatile("" : "+v"(l_)); fr = l_ & 15; fq = l_ >> 4;
        const int row0 = u.pm * BM + wr * 64 + fr, col0 = u.pn * BM + wc * 32 + 8 * fq;
        {
            u32x4 bv[2][4][2];
#pragma unroll
            for (int ai = 0; ai < 2; ++ai)
#pragma unroll
                for (int m = 0; m < 4; ++m) { const size_t off = (size_t)(row0 + ai * HALF + m * 16) * ldc + col0;
#pragma unroll
                    for (int bj = 0; bj < 2; ++bj) bv[ai][m][bj] = __builtin_nontemporal_load((const u32x4*)(hb + off + bj * HALF)); }
#pragma unroll
            for (int ai = 0; ai < 2; ++ai)
#pragma unroll
                for (int m = 0; m < 4; ++m) { const int r = row0 + ai * HALF + m * 16; float s = 0.f;
#pragma unroll
                    for (int bj = 0; bj < 2; ++bj) { const u32x4 b = bv[ai][m][bj];
                        f32x4 o0 = acc[ai][bj][m][0], o1 = acc[ai][bj][m][1];
                        o0[0] += __builtin_bit_cast(float, b.x << 16); o0[1] += __builtin_bit_cast(float, b.x & 0xffff0000u);
                        o0[2] += __builtin_bit_cast(float, b.y << 16); o0[3] += __builtin_bit_cast(float, b.y & 0xffff0000u);
                        o1[0] += __builtin_bit_cast(float, b.z << 16); o1[1] += __builtin_bit_cast(float, b.z & 0xffff0000u);
                        o1[2] += __builtin_bit_cast(float, b.w << 16); o1[3] += __builtin_bit_cast(float, b.w & 0xffff0000u);
                        s += ((o0[0] * o0[0] + o0[1] * o0[1]) + (o0[2] * o0[2] + o0[3] * o0[3])) + ((o1[0] * o1[0] + o1[1] * o1[1]) + (o1[2] * o1[2] + o1[3] * o1[3]));
                        acc[ai][bj][m][0] = o0; acc[ai][bj][m][1] = o1; }
                    s += __shfl_xor(s, 16); s += __shfl_xor(s, 32);
                    if (fq == 0) atomicAdd(ssq + r, s); }
        }
        asm volatile("s_waitcnt vmcnt(0)" ::: "memory");
        unsigned* c = cnt + (u.pm * 2 + wr) * 16;
        if (l_ == 0) (void)__hip_atomic_fetch_add(c, 1u, __ATOMIC_RELAXED, __HIP_MEMORY_SCOPE_AGENT);
        f32x4 gv[2][2];
#pragma unroll
        for (int bj = 0; bj < 2; ++bj)
#pragma unroll
            for (int n = 0; n < 2; ++n) gv[bj][n] = *(const f32x4*)(gf + col0 + bj * HALF + 4 * n);
        { unsigned sp = 0u;
          while (__hip_atomic_load(c, __ATOMIC_RELAXED, __HIP_MEMORY_SCOPE_AGENT) < need) { __builtin_amdgcn_s_sleep(1);
              if ((++sp & 255u) == 0u) { if (__hip_atomic_load(tmo, __ATOMIC_RELAXED, __HIP_MEMORY_SCOPE_AGENT)) break; if (sp > (1u << 20)) { atomicAdd(tmo, 1u); break; } } } }
        float iv[2][4];
#pragma unroll
        for (int ai = 0; ai < 2; ++ai)
#pragma unroll
            for (int m = 0; m < 4; ++m) iv[ai][m] = __hip_atomic_load(ssq + row0 + ai * HALF + m * 16, __ATOMIC_RELAXED, __HIP_MEMORY_SCOPE_AGENT);
#pragma unroll
        for (int ai = 0; ai < 2; ++ai)
#pragma unroll
            for (int m = 0; m < 4; ++m) { const float inv = 1.0f / sqrtf(iv[ai][m] * (1.0f / DM) + EPS); float* rowp = out + (size_t)(row0 + ai * HALF + m * 16) * ldc + col0;
#pragma unroll
                for (int bj = 0; bj < 2; ++bj) { *(f32x4*)(rowp + bj * HALF) = acc[ai][bj][m][0] * inv * gv[bj][0]; *(f32x4*)(rowp + bj * HALF + 4) = acc[ai][bj][m][1] * inv * gv[bj][1]; } }
    }
};
struct EpiY {
    static constexpr bool PERM = true, AFTER_DRAIN = false;
    bf16_t* O; int ldc;
    __device__ __forceinline__ void operator()(const f32x4 (&acc)[2][2][4][2], const Unit& u, int wr, int wc, int fr, int fq) const {
        { int l_ = (int)lane_id_fresh(); asm volatile("" : "+v"(l_)); fr = l_ & 15; fq = l_ >> 4; }
        const int rl0 = wr * 64 + fr, col0 = u.pn * BM + wc * 32 + 8 * fq; const int tok0 = (u.pm >> 4) * 4096 + (u.pm & 15);
#pragma unroll
        for (int ai = 0; ai < 2; ++ai)
#pragma unroll
            for (int m = 0; m < 4; ++m) { const int rl = rl0 + ai * HALF + m * 16; bf16_t* rowp = O + (size_t)(tok0 + 16 * rl) * ldc + col0;
#pragma unroll
                for (int bj = 0; bj < 2; ++bj) { const f32x4 v0 = acc[ai][bj][m][0], v1 = acc[ai][bj][m][1];
                    u32x4 w; w.x = cvt_pk_bf16(v0[0], v0[1]); w.y = cvt_pk_bf16(v0[2], v0[3]); w.z = cvt_pk_bf16(v1[0], v1[1]); w.w = cvt_pk_bf16(v1[2], v1[3]);
                    *(u32x4*)(rowp + bj * HALF) = w; } }
    }
};

typedef int v4i_t __attribute__((ext_vector_type(4)));
template <class Epi, class Sched, class Addr, bool ALIGN_EPI, int TSW = 0>
__device__ __forceinline__ void gemm_phase(PG8_LAS unsigned char* lds, const int K, const Addr g, const Sched& S, const Epi& E, const int wid  ) {
    int lane_ = (int)lane_id_fresh(); asm volatile("" : "+v"(lane_));
    const int lane = lane_, tid = wid * 64 + lane, wr = wid >> 2, wc = wid & 3, fr = lane & 15, fq = lane >> 4;
    const int nt = K / BK;
    unsigned voffA[2], voffB[2];
#pragma unroll
    for (int i = 0; i < 2; ++i) { int R, C; stage_rc(tid * 16 + i * 8192, R, C); const int Rb = Epi::PERM ? ((R & ~31) + perm32(R & 31)) : R;
        voffA[i] = g.voffA(R, C); voffB[i] = g.voffB(Rb, C); }
    const size_t kstep = (size_t)(BK * 2);
    const size_t hstepA = g.hA(), hstepB = g.hB();
    const unsigned ldsw = (unsigned)wid * 1024u;
    const int aoff = lds_byte(wr * 64 + fr, fq * 8), boff = lds_byte(wc * 32 + fr, fq * 8);
#define PG8_SA(b, h) (((b) * 2 + (h)) * HTB)
#define PG8_SB(b, h) ((4 + (b) * 2 + (h)) * HTB)
#define PG8_STAGE(bufoff, gbase, voff) do { _Pragma("unroll") for (int _i = 0; _i < 2; ++_i) { unsigned _vo = (voff)[_i]; asm volatile("" : "+v"(_vo)); \
        __builtin_amdgcn_global_load_lds((const PG8_GAS unsigned*)((const PG8_GAS char*)(gbase) + _vo), (PG8_LAS unsigned*)(lds + (bufoff) + ldsw + _i * 8192), 16, 0, 0); } } while (0)
#define PG8_LDA(dst, b, h) do { _Pragma("unroll") for (int m = 0; m < 4; ++m) _Pragma("unroll") for (int k = 0; k < 2; ++k) dst[m][k] = *(const PG8_LAS bf16x8*)(lds + PG8_SA(b, h) + aoff + m * 2048 + k * 1024); } while (0)
#define PG8_LDB(dst, b, h) do { _Pragma("unroll") for (int n = 0; n < 2; ++n) _Pragma("unroll") for (int k = 0; k < 2; ++k) dst[n][k] = *(const PG8_LAS bf16x8*)(lds + PG8_SB(b, h) + boff + n * 2048 + k * 1024); } while (0)
#define PG8_MMA(ai, bj, At, Bt) do { __builtin_amdgcn_s_setprio(1); _Pragma("unroll") for (int m = 0; m < 4; ++m) _Pragma("unroll") for (int n = 0; n < 2; ++n) _Pragma("unroll") for (int k = 0; k < 2; ++k) \
        acc[ai][bj][m][n] = __builtin_amdgcn_mfma_f32_16x16x32_bf16(Bt[n][k], At[m][k], acc[ai][bj][m][n], 0, 0, 0); __builtin_amdgcn_s_setprio(0); } while (0)
#define PG8_CAT(x, y) __builtin_shufflevector(__builtin_bit_cast(v4i_t, x), __builtin_bit_cast(v4i_t, y), 0, 1, 2, 3, 4, 5, 6, 7)
#define PG8_MMA8(ai, bj, At, Bt) do { __builtin_amdgcn_s_setprio(1); _Pragma("unroll") for (int m = 0; m < 4; ++m) _Pragma("unroll") for (int n = 0; n < 2; ++n) \
        acc[ai][bj][m][n] = __builtin_amdgcn_mfma_scale_f32_16x16x128_f8f6f4(PG8_CAT(Bt[n][0], Bt[n][1]), PG8_CAT(At[m][0], At[m][1]), acc[ai][bj][m][n], 0, 0, 0, 0, 0, 0); __builtin_amdgcn_s_setprio(0); } while (0)
#define PG8_WAIT_V(n) asm volatile("s_waitcnt vmcnt(" #n ")" ::: "memory")
#define PG8_WAIT_L(n) asm volatile("s_waitcnt lgkmcnt(" #n ")" ::: "memory")
#define PG8_BAR __builtin_amdgcn_s_barrier()
#define PG8_SCHED __builtin_amdgcn_sched_barrier(0)
    Unit cur, nxt; int ui = 0;
    if (!S.next(0, cur)) return;
    f32x4 acc[2][2][4][2];
#pragma unroll
    for (int a = 0; a < 2; ++a)
#pragma unroll
        for (int b = 0; b < 2; ++b)
#pragma unroll
            for (int m = 0; m < 4; ++m)
#pragma unroll
                for (int n = 0; n < 2; ++n) acc[a][b][m][n] = (f32x4){0.f, 0.f, 0.f, 0.f};
    bf16x8 At[4][2], B0[2][2], B1[2][2];
    const char* cA = g.a(cur); const char* cB = g.b(cur);
    S.a_ready(cur);
    PG8_STAGE(PG8_SB(0, 0), cB, voffB); PG8_STAGE(PG8_SB(0, 1), cB + hstepB, voffB); PG8_STAGE(PG8_SA(0, 0), cA, voffA); PG8_STAGE(PG8_SA(0, 1), cA + hstepA, voffA);
    if (wr == 1) PG8_BAR;
    PG8_WAIT_V(2); PG8_BAR;
    PG8_STAGE(PG8_SB(1, 0), cB + kstep, voffB); PG8_STAGE(PG8_SA(1, 0), cA + kstep, voffA); PG8_STAGE(PG8_SB(1, 1), cB + hstepB + kstep, voffB);
    PG8_WAIT_V(6); PG8_BAR;
    for (;;) {
        const bool has_next = S.next(ui + 1, nxt);
        const char* nA = has_next ? g.a(nxt) : cA;
        const char* nB = has_next ? g.b(nxt) : cB;
#define PG8_BODY(MM) \
            const bool last = (t == nt - 2); \
            const char* a1 = cA + (size_t)(t + 1) * kstep; \
            const char* a2 = last ? nA : cA + (size_t)(t + 2) * kstep; const char* b2 = last ? nB : cB + (size_t)(t + 2) * kstep; \
            const char* a3 = a2 + kstep; const char* b3 = b2 + kstep; \
            if (last && has_next) S.a_ready(nxt); \
            PG8_LDB(B0, 0, 0); PG8_LDB(B1, 0, 1); PG8_SCHED; PG8_LDA(At, 0, 0); PG8_STAGE(PG8_SA(1, 1), a1 + hstepA, voffA); \
            PG8_WAIT_V(8); PG8_WAIT_L(0); PG8_BAR; MM(0, 0, At, B0); MM(0, 1, At, B1); PG8_BAR; PG8_SCHED; \
            PG8_LDA(At, 0, 1); PG8_STAGE(PG8_SB(0, 0), b2, voffB); PG8_STAGE(PG8_SB(0, 1), b2 + hstepB, voffB); PG8_STAGE(PG8_SA(0, 0), a2, voffA); \
            PG8_WAIT_V(8); PG8_WAIT_L(0); PG8_BAR; MM(1, 0, At, B0); MM(1, 1, At, B1); PG8_BAR; PG8_SCHED; \
            PG8_LDB(B0, 1, 0); PG8_LDB(B1, 1, 1); PG8_SCHED; PG8_LDA(At, 1, 0); PG8_STAGE(PG8_SA(0, 1), a2 + hstepA, voffA); \
            PG8_WAIT_V(8); PG8_WAIT_L(0); PG8_BAR; MM(0, 0, At, B0); MM(0, 1, At, B1); PG8_BAR; PG8_SCHED; \
            PG8_LDA(At, 1, 1); PG8_STAGE(PG8_SB(1, 0), b3, voffB); PG8_STAGE(PG8_SB(1, 1), b3 + hstepB, voffB); PG8_STAGE(PG8_SA(1, 0), a3, voffA); \
            PG8_WAIT_V(8); PG8_WAIT_L(0); PG8_BAR; MM(1, 0, At, B0); MM(1, 1, At, B1); PG8_BAR; PG8_SCHED;
        { const int tmid = (TSW > 0 && TSW < nt) ? TSW : nt;
          _Pragma("unroll 1") for (int t = 0; t < tmid; t += 2) { PG8_BODY(PG8_MMA) }
          if constexpr (TSW > 0) { _Pragma("unroll 1") for (int t = tmid; t < nt; t += 2) { PG8_BODY(PG8_MMA8) } } }
#undef PG8_BODY
        if constexpr (ALIGN_EPI) { if (wr == 0) PG8_BAR; }
        E(acc, cur, wr, wc, 0, 0); S.done(cur);
        if (!has_next) break;
#pragma unroll
        for (int a = 0; a < 2; ++a)
#pragma unroll
            for (int b = 0; b < 2; ++b)
#pragma unroll
                for (int m = 0; m < 4; ++m)
#pragma unroll
                    for (int n = 0; n < 2; ++n) acc[a][b][m][n] = (f32x4){0.f, 0.f, 0.f, 0.f};
        cur = nxt; cA = nA; cB = nB; ++ui;
        if constexpr (ALIGN_EPI) { if (wr == 1) PG8_BAR; }
    }
    if constexpr (!Epi::AFTER_DRAIN) PG8_WAIT_V(0);
    if constexpr (!ALIGN_EPI) { if (wr == 0) PG8_BAR; }
    PG8_BAR;
#undef PG8_SA
#undef PG8_SB
#undef PG8_STAGE
#undef PG8_LDA
#undef PG8_LDB
#undef PG8_MMA
#undef PG8_MMA8
#undef PG8_CAT
#undef PG8_WAIT_V
#undef PG8_WAIT_L
#undef PG8_BAR
#undef PG8_SCHED
}
}

typedef unsigned short bf16_t;
typedef short bf16x8 __attribute__((ext_vector_type(8)));
typedef float f32x4 __attribute__((ext_vector_type(4)));
typedef unsigned v4u __attribute__((ext_vector_type(4)));
#define GAS __attribute__((address_space(1)))
#define LAS __attribute__((address_space(3)))
using pg8::lane_id_fresh;
constexpr int NWAVES = 8;
constexpr int WGM_F = 16, WGM_Q = 8, WGM_O = 1, WGM_U = 4, WGM_D = 4;

constexpr size_t MiB = 1u << 20;
constexpr size_t WS_CTL = 0, CTL_ZERO_BYTES = 1 * MiB;
constexpr int CW_BAR = 4096;
constexpr int CW_EXCH = 16384;
constexpr size_t WS_SSQ1 = 256 * 1024;
constexpr size_t WS_SSQ2 = 384 * 1024;
constexpr size_t WS_INV0 = 1 * MiB;
constexpr size_t WS_TRIG2 = 3 * MiB;
constexpr size_t WS_ABT  = 2 * MiB;
constexpr size_t WS_WINT = 4 * MiB;
constexpr size_t WS_WO   = 28 * MiB;
constexpr size_t WS_WUP  = 36 * MiB;
constexpr size_t WS_WD   = 68 * MiB;
constexpr size_t WS_H1B  = 100 * MiB;
constexpr size_t WS_XB   = 164 * MiB;
constexpr size_t WS_Y    = 324 * MiB;
constexpr size_t WS_Q    = 228 * MiB;
constexpr size_t WS_ZT   = 388 * MiB;
constexpr size_t WS_A    = 324 * MiB;
constexpr size_t WS_END  = 452 * MiB;
static_assert(WS_SSQ2 + (size_t)T * 4 <= CTL_ZERO_BYTES, "ssq inside the memset region");

constexpr int RING_BYTES = 131072;
constexpr int LDSCTL_OFF = RING_BYTES, MISC_OFF = LDSCTL_OFF + 320;
constexpr int LDS_BYTES = 147456;

#define LDS_WAIT() asm volatile("s_waitcnt lgkmcnt(0)" ::: "memory")
__device__ __forceinline__ unsigned f2bf(float f) { unsigned u = __builtin_bit_cast(unsigned, f); return (u + 0x7fffu + ((u >> 16) & 1u)) >> 16; }
__device__ __forceinline__ unsigned pk2(float lo, float hi) { return f2bf(lo) | (f2bf(hi) << 16); }
__device__ __forceinline__ float bf2f(unsigned v) { return __builtin_bit_cast(float, v << 16); }
__device__ __forceinline__ float wave_sum(float v) {
#pragma unroll
    for (int o = 1; o < 64; o <<= 1) v += __shfl_xor(v, o);
    return v;
}
__device__ __forceinline__ float wave_max(float v) {
#pragma unroll
    for (int o = 1; o < 64; o <<= 1) v = fmaxf(v, __shfl_xor(v, o));
    return v;
}

#define XB_TMO      128
#define XB_XCNT(j)  (256  + 64 * (j))
#define XB_XSUB(j)  (1280 + 64 * (j))
#define XB_XGEN(j)  (2304 + 64 * (j))
#define XB_TOP      3328
#define XB_TOPGEN   3392
#define XCD_BAR_WORDS 3456
#define XB_SPIN_CAP (1u << 20)
__device__ __forceinline__ unsigned xb_ld(unsigned* p)              { return __hip_atomic_load(p, __ATOMIC_RELAXED, __HIP_MEMORY_SCOPE_AGENT); }
__device__ __forceinline__ unsigned xb_add(unsigned* p, unsigned v) { return __hip_atomic_fetch_add(p, v, __ATOMIC_RELAXED, __HIP_MEMORY_SCOPE_AGENT); }
__device__ __forceinline__ unsigned xb_xcc_id() { return (unsigned)__builtin_amdgcn_s_getreg((3 << 11) | 20) & 0xFu; }
#define XB_SPIN(cond, bar) do { unsigned _sp = 0; while (cond) { __builtin_amdgcn_s_sleep(1); \
    if ((++_sp & 255u) == 0u) { if (xb_ld(&(bar)[XB_TMO])) break; if (_sp > XB_SPIN_CAP) { atomicAdd(&(bar)[XB_TMO], 1u); break; } } } } while (0)
struct XcdBarrier { unsigned* bar; unsigned x; volatile LAS unsigned* st; };
__device__ __forceinline__ XcdBarrier xcd_barrier_post(unsigned* bar, volatile LAS unsigned* st) {
    XcdBarrier b; b.bar = bar; b.x = xb_xcc_id(); b.st = st;
    if (threadIdx.x == 0) (void)xb_add(&bar[XB_XCNT(b.x)], 1u);
    return b;
}
__device__ __forceinline__ void xcd_barrier_complete(unsigned* bar, unsigned x, unsigned& nloc, unsigned& nx) {
    const unsigned G = gridDim.x * gridDim.y * gridDim.z;
    unsigned sum, cnt, mine, sp = 0u;
    for (;;) {
        sum = 0u; cnt = 0u; mine = 0u;
#pragma unroll
        for (unsigned j = 0; j < 16; ++j) { const unsigned c = xb_ld(&bar[XB_XCNT(j)]); sum += c; cnt += (c > 0u) ? 1u : 0u; mine = (j == x) ? c : mine; }
        if (sum == G) break;
        __builtin_amdgcn_s_sleep(1);
        if ((++sp & 255u) == 0u) { if (xb_ld(&bar[XB_TMO])) break; if (sp > XB_SPIN_CAP) { atomicAdd(&bar[XB_TMO], 1u); break; } }
    }
    nloc = mine > 0u ? mine : 1u; nx = cnt > 0u ? cnt : 1u;
}
__device__ __forceinline__ void xcd_barrier(const XcdBarrier& b, const int wave) {
    asm volatile("s_waitcnt vmcnt(0)" ::: "memory");
    __syncthreads();
    if (wave == 0 && lane_id_fresh() == 0u) {
        unsigned* bar = b.bar;
        __builtin_amdgcn_s_waitcnt(0);
        unsigned nloc = b.st[0], nx = b.st[1];
        if (nloc == 0u) { xcd_barrier_complete(bar, b.x, nloc, nx); b.st[0] = nloc; b.st[1] = nx; }
        const unsigned old = xb_add(&bar[XB_XSUB(b.x)], 1u);
        const unsigned gen = old / nloc;
        if (old + 1u == (gen + 1u) * nloc) {
            __builtin_amdgcn_fence(__ATOMIC_RELEASE, "agent");
            asm volatile("s_waitcnt vmcnt(0)" ::: "memory");
            const unsigned og = xb_add(&bar[XB_TOP], 1u);
            const unsigned tg = og / nx;
            if (og + 1u == (tg + 1u) * nx) xb_add(&bar[XB_TOPGEN], 1u);
            else XB_SPIN(xb_ld(&bar[XB_TOPGEN]) == tg, bar);
            __builtin_amdgcn_fence(__ATOMIC_ACQUIRE, "agent");
            xb_add(&bar[XB_XGEN(b.x)], 1u);
            asm volatile("s_waitcnt vmcnt(0)" ::: "memory");
        } else {
            XB_SPIN(xb_ld(&bar[XB_XGEN(b.x)]) == gen, bar);
            __builtin_amdgcn_fence(__ATOMIC_ACQUIRE, "agent");
            asm volatile("s_waitcnt vmcnt(0)" ::: "memory");
        }
    }
    __syncthreads();
}

__device__ __forceinline__ void p0_transpose_item(const float* W, int ldw, int col_off, int K, int N, const float* rs, bf16_t* WT, LAS float* scr, int item, int lane) {
    const int nblk = N / 32, kb = item / nblk, nb = item % nblk, k0 = 64 * kb, n0 = 32 * nb;
    const int r8 = lane >> 3, c4 = (lane & 7) * 4;
    f32x4 v[8]; float sc[8];
#pragma unroll
    for (int i = 0; i < 8; ++i) { const int kk = 8 * i + r8; v[i] = __builtin_nontemporal_load((const GAS f32x4*)(W + (size_t)(k0 + kk) * ldw + col_off + n0 + c4)); sc[i] = rs ? rs[k0 + kk] : 1.0f; }
#pragma unroll
    for (int i = 0; i < 8; ++i) { LAS float* d = scr + (8 * i + r8) * 33 + c4; d[0] = v[i].x * sc[i]; d[1] = v[i].y * sc[i]; d[2] = v[i].z * sc[i]; d[3] = v[i].w * sc[i]; }
    LDS_WAIT();
    const int c = lane & 7;
#pragma unroll
    for (int j = 0; j < 4; ++j) { const int n = (lane >> 3) + 8 * j; const LAS float* s = scr + (8 * c) * 33 + n;
        v4u o; o.x = pk2(s[0 * 33], s[1 * 33]); o.y = pk2(s[2 * 33], s[3 * 33]); o.z = pk2(s[4 * 33], s[5 * 33]); o.w = pk2(s[6 * 33], s[7 * 33]);
        *(GAS v4u*)(WT + (size_t)(n0 + n) * K + k0 + 8 * c) = o; }
    LDS_WAIT();
}

__device__ __forceinline__ void p0_transpose_item_wo(const float* W, bf16_t* WT, LAS float* scr, int item, int lane) {
    const int kb = item >> 6, nb = item & 63, k0 = 64 * kb, n0 = 32 * nb;
    const int r8 = lane >> 3, c4 = (lane & 7) * 4;
    f32x4 v[8];
#pragma unroll
    for (int i = 0; i < 8; ++i) { const int kk = 8 * i + r8; v[i] = __builtin_nontemporal_load((const GAS f32x4*)(W + (size_t)(k0 + kk) * 2048 + n0 + c4)); }
#pragma unroll
    for (int i = 0; i < 8; ++i) { LAS float* d = scr + (8 * i + r8) * 33 + c4; d[0] = v[i].x * 32.f; d[1] = v[i].y * 32.f; d[2] = v[i].z * 32.f; d[3] = v[i].w * 32.f; }
    LDS_WAIT();
    const int c = lane & 7;
#pragma unroll
    for (int j = 0; j < 4; ++j) { const int n = (lane >> 3) + 8 * j; const LAS float* s = scr + (8 * c) * 33 + n;
        GAS unsigned char* row = (GAS unsigned char*)WT + (size_t)(n0 + n) * 3072;
        if (k0 < 1024) { v4u o; o.x = pk2(s[0 * 33], s[1 * 33]); o.y = pk2(s[2 * 33], s[3 * 33]); o.z = pk2(s[4 * 33], s[5 * 33]); o.w = pk2(s[6 * 33], s[7 * 33]);
            *(GAS v4u*)(row + (k0 + 8 * c) * 2) = o; }
        else { pg8::u32x2 o; o.x = pg8::pk_fp8x4((f32x4){s[0 * 33], s[1 * 33], s[2 * 33], s[3 * 33]}); o.y = pg8::pk_fp8x4((f32x4){s[4 * 33], s[5 * 33], s[6 * 33], s[7 * 33]});
            *(GAS pg8::u32x2*)(row + 2048 + (k0 - 1024) + 8 * c) = o; } }
    LDS_WAIT();
}

typedef float f32x16 __attribute__((ext_vector_type(16)));
typedef short s16x4 __attribute__((ext_vector_type(4)));
typedef unsigned u32x2 __attribute__((ext_vector_type(2)));
typedef float f32x2 __attribute__((ext_vector_type(2)));
__device__ __forceinline__ unsigned cvtpk(float lo, float hi) { unsigned r; asm volatile("v_cvt_pk_bf16_f32 %0, %1, %2" : "=v"(r) : "v"(lo), "v"(hi)); return r; }
#define SBAR() __builtin_amdgcn_sched_barrier(0)
constexpr float AT_THR = 8.0f;
constexpr int at_v_rd_off(int d0, int ks, int half) { return d0 * 512 + ks * 4096 + half * 2048; }
template <int OFF> __device__ __forceinline__ s16x4 tr_read(unsigned vb) {
    s16x4 r; asm volatile("ds_read_b64_tr_b16 %0, %1 offset:%2" : "=&v"(r) : "v"(vb), "i"(OFF) : "memory"); return r;
}
__device__ __forceinline__ int clampi(int v, int lo, int hi) { return v < lo ? lo : (v > hi ? hi : v); }
__device__ __forceinline__ void at_dma_k(LAS unsigned char* kdst, const bf16_t* kbase, int tq0, int dil, int tile, int lane_) {
    int lane = lane_; asm volatile("" : "+v"(lane));
    const int r0 = lane >> 3; const unsigned c0 = (unsigned)(((lane & 7) ^ r0) << 4);
    const int t0 = tq0 + dil * (32 * tile + r0 - 64), d8 = 8 * dil;
#pragma unroll
    for (int n = 0; n < 4; ++n) { int tkn = t0 + n * d8; tkn = tkn < 0 ? 0 : (tkn > SEQ - 1 ? SEQ - 1 : tkn);
        const unsigned off = ((unsigned)tkn << 7) + c0;
        __builtin_amdgcn_global_load_lds((const unsigned*)((const GAS char*)kbase + off), (LAS unsigned*)(kdst + n * 1024), 16, 0, 0); }
}
__device__ __forceinline__ long bf16x8_to_fp8(const bf16x8 v) {
    const v4u w = __builtin_bit_cast(v4u, v);
    int lo = __builtin_amdgcn_cvt_pk_fp8_f32(__builtin_bit_cast(float, w.x << 16), __builtin_bit_cast(float, w.x & 0xffff0000u), 0, false);
    lo = __builtin_amdgcn_cvt_pk_fp8_f32(__builtin_bit_cast(float, w.y << 16), __builtin_bit_cast(float, w.y & 0xffff0000u), lo, true);
    int hi = __builtin_amdgcn_cvt_pk_fp8_f32(__builtin_bit_cast(float, w.z << 16), __builtin_bit_cast(float, w.z & 0xffff0000u), 0, false);
    hi = __builtin_amdgcn_cvt_pk_fp8_f32(__builtin_bit_cast(float, w.w << 16), __builtin_bit_cast(float, w.w & 0xffff0000u), hi, true);
    return (long)(((unsigned long long)(unsigned)hi << 32) | (unsigned long long)(unsigned)lo);
}
__device__ __forceinline__ void at_dma_v(LAS unsigned char* vdst, const bf16_t* vbase, int tq0, int dil, int tile, int lane_) { at_dma_k(vdst, vbase, tq0, dil, tile, lane_); }
template <int OFF> __device__ __forceinline__ long tr8_read(unsigned vb) {
    long r; asm volatile("ds_read_b64_tr_b8 %0, %1 offset:%2" : "=&v"(r) : "v"(vb), "i"(OFF) : "memory"); return r;
}
constexpr int TRB8_MAP = 0;
__device__ __forceinline__ void at_load_q(bf16x8 (&qr)[8], const bf16_t* qb, int tq0, int dil, int lane) {
    const bf16_t* qrow = qb + (size_t)(tq0 + dil * (lane & 31)) * 128 + (lane >> 5) * 8;
#pragma unroll
    for (int s = 0; s < 8; ++s) qr[s] = *(const GAS bf16x8*)(qrow + 16 * s);
}
__device__ __forceinline__ void at_unit_prologue(LAS unsigned char* wl, bf16x8 (&qr)[8], const bf16_t* qb, const bf16_t* kb, const bf16_t* vb, int tq0, int dil, int lane) {
    at_dma_k(wl, kb, tq0, dil, 0, lane); at_dma_v(wl + 8192, vb, tq0, dil, 0, lane); at_load_q(qr, qb, tq0, dil, lane);
}
__device__ __forceinline__ void attn_unit(const bool FINAL, const bool HN, LAS unsigned char* wl, const bf16_t* qb, const bf16_t* kb, const bf16_t* vb, int tq0, int dil, float sl, bf16x8 (&qr)[8], const bf16_t* nqb, const bf16_t* nkb, const bf16_t* nvb, int ntq0, int ndil,
                                          bf16_t* part, float* ml, const bf16_t* part0, const bf16_t* part1, const float* ml0, const float* ml1, bf16_t* yout, int lane) {
    const int r32 = lane & 31, hi = lane >> 5;
    LAS unsigned char* kbuf = wl; LAS unsigned char* vbuf = wl + 8192;
    const int jlo = 64 - tq0 / dil, jhi = 64 + (SEQ - 1 - tq0) / dil;
    const float lo_i = (float)max(-64, jlo - 64 - r32), hi_i = (float)min(64, jhi - 64 - r32);
    const bool interior = (jlo <= 0) && (jhi >= 159);
    float m_run = -1e30f, l_run = 0.f;
    f32x16 oT[4];
#pragma unroll
    for (int d0 = 0; d0 < 4; ++d0)
#pragma unroll
        for (int r = 0; r < 16; ++r) oT[d0][r] = 0.f;
    asm volatile("s_waitcnt vmcnt(0)" ::: "memory");
#pragma unroll
    for (int s = 0; s < 8; ++s) asm volatile("" : "+v"(qr[s]));
    long q8[8];
#pragma unroll
    for (int s = 0; s < 8; ++s) q8[s] = bf16x8_to_fp8(qr[s]);
    f32x2 st1 = {0.f, 0.f}, st2 = {0.f, 0.f};
    if (FINAL) { const size_t tqs = (size_t)(tq0 + dil * r32) * 2; st1 = *(const GAS f32x2*)(ml0 + tqs); st2 = *(const GAS f32x2*)(ml1 + tqs); }
    const int rr0 = lane >> 4, cs = lane & 15;
    const LAS unsigned char* krd = kbuf + r32 * 128 + hi * 8;
    const int kx = (r32 & 7) << 4;
#pragma unroll 1
    for (int n = 0; n < 5; ++n) {
        if (n > 0) asm volatile("s_waitcnt vmcnt(4)" ::: "memory");
        SBAR();
        long kf[8];
#pragma unroll
        for (int s = 0; s < 8; ++s) kf[s] = *(const LAS long*)(krd + ((16 * s) ^ kx));
        asm volatile("s_waitcnt lgkmcnt(0)" ::: "memory"); SBAR();
        unsigned toff[4];
        if (n < 4 || HN) {
            const bf16_t* kbp = (n < 4) ? kb : nkb; const int ktq = (n < 4) ? tq0 : ntq0, kdl = (n < 4) ? dil : ndil, ktl = (n < 4) ? n + 1 : 0;
            int kl = lane; asm volatile("" : "+v"(kl));
            const int kr0 = kl >> 3; const unsigned kc0 = (unsigned)(((kl & 7) ^ kr0) << 4);
            const int kt0 = ktq + kdl * (32 * ktl + kr0 - 64), kd8 = 8 * kdl;
            if (interior && n < 4) {
#pragma unroll
                for (int i = 0; i < 4; ++i) toff[i] = ((unsigned)(kt0 + i * kd8) << 7) + kc0;
            } else {
#pragma unroll
                for (int i = 0; i < 4; ++i) { int tkn = kt0 + i * kd8; tkn = tkn < 0 ? 0 : (tkn > SEQ - 1 ? SEQ - 1 : tkn); toff[i] = ((unsigned)tkn << 7) + kc0; }
            }
#pragma unroll
            for (int i = 0; i < 4; ++i) __builtin_amdgcn_global_load_lds((const unsigned*)((const GAS char*)kbp + toff[i]), (LAS unsigned*)(kbuf + i * 1024), 16, 0, 0);
        }
        f32x16 p;
#pragma unroll
        for (int r = 0; r < 16; ++r) p[r] = 0.f;
#pragma unroll
        for (int s = 0; s < 8; ++s) p = __builtin_amdgcn_mfma_f32_32x32x16_fp8_fp8(kf[s], q8[s], p, 0, 0, 0);
        const float relb = (float)(32 * n + 4 * hi - 64 - r32) - 8.0f;
#define AT_CR(r) ((float)(((r) & 3) + 8 * ((r) >> 2) + 8))
        float tmax = -1e30f;
        if (interior && n == 2) {
#pragma unroll
            for (int r = 0; r < 16; ++r) { const float rel = relb + AT_CR(r); p[r] = p[r] - sl * fabsf(rel); tmax = fmaxf(tmax, p[r]); }
        } else if (interior) {
            const float ssl = (n < 2) ? sl : -sl;
            if (n == 0) {
#pragma unroll
                for (int r = 0; r < 16; ++r) { const float rel = relb + AT_CR(r); const float v = __builtin_fmaf(ssl, rel, p[r]); p[r] = (rel >= -64.f) ? v : -1e30f; tmax = fmaxf(tmax, p[r]); }
            } else if (n == 4) {
#pragma unroll
                for (int r = 0; r < 16; ++r) { const float rel = relb + AT_CR(r); const float v = __builtin_fmaf(ssl, rel, p[r]); p[r] = (rel <= 64.f) ? v : -1e30f; tmax = fmaxf(tmax, p[r]); }
            } else {
#pragma unroll
                for (int r = 0; r < 16; ++r) { const float rel = relb + AT_CR(r); p[r] = __builtin_fmaf(ssl, rel, p[r]); tmax = fmaxf(tmax, p[r]); }
            }
        } else {
#pragma unroll
            for (int r = 0; r < 16; ++r) { const float rel = relb + AT_CR(r); const bool ok = (rel >= lo_i) && (rel <= hi_i);
                p[r] = ok ? p[r] - sl * fabsf(rel) : -1e30f; tmax = fmaxf(tmax, p[r]); }
        }
#undef AT_CR
        { auto rr = __builtin_amdgcn_permlane32_swap(__float_as_uint(tmax), __float_as_uint(tmax), false, false); tmax = fmaxf(__uint_as_float(rr[0]), __uint_as_float(rr[1])); }
        float mn = m_run, alpha = 1.f;
        if (!__all(tmax - m_run <= AT_THR)) { mn = fmaxf(m_run, tmax); alpha = __builtin_amdgcn_exp2f(m_run - mn); m_run = mn;
            if (n > 0) {
#pragma unroll
            for (int d0 = 0; d0 < 4; ++d0)
#pragma unroll
                for (int r = 0; r < 16; ++r) oT[d0][r] *= alpha; } }
        float ps = 0.f;
#pragma unroll
        for (int r = 0; r < 16; ++r) { p[r] = __builtin_amdgcn_exp2f(p[r] - mn); ps += p[r]; }
        { auto rr = __builtin_amdgcn_permlane32_swap(__float_as_uint(ps), __float_as_uint(ps), false, false); ps = __uint_as_float(rr[0]) + __uint_as_float(rr[1]); }
        l_run = l_run * alpha + ps;
        long pa0, pa1;
#define AT_PK8(P, BASE, OUT) do { const unsigned a4 = pg8::pk_fp8x4((f32x4){P[BASE + 0], P[BASE + 1], P[BASE + 2], P[BASE + 3]}), b4 = pg8::pk_fp8x4((f32x4){P[BASE + 4], P[BASE + 5], P[BASE + 6], P[BASE + 7]}); \
        auto r0 = __builtin_amdgcn_permlane32_swap(a4, b4, false, false); OUT = (long)(((unsigned long long)r0[1] << 32) | (unsigned long long)r0[0]); } while (0)
        AT_PK8(p, 0, pa0); AT_PK8(p, 8, pa1);
#undef AT_PK8
        if (n < 4 || HN) asm volatile("s_waitcnt vmcnt(4)" ::: "memory");
        else asm volatile("s_waitcnt vmcnt(0)" ::: "memory");
        SBAR();
        {
            int vl_ = lane; asm volatile("" : "+v"(vl_));
            const int vg = vl_ & 15, vgrp = vl_ >> 4, vr = TRB8_MAP ? (vg & 7) : (vg >> 1), vc = TRB8_MAP ? (vg >> 3) : (vg & 1);
            const unsigned vb0 = (unsigned)(uintptr_t)vbuf + (unsigned)((8 * (vgrp >> 1) + vr) * 128 + 8 * vc);
            long vf[4][2];
#define AT_RD8(D0) do { const unsigned va_ = vb0 + (unsigned)((((2 * D0 + (vgrp & 1)) ^ vr) & 7) << 4); vf[D0][0] = tr8_read<0>(va_); vf[D0][1] = tr8_read<2048>(va_); } while (0)
            AT_RD8(0); AT_RD8(1); AT_RD8(2); AT_RD8(3);
#undef AT_RD8
            asm volatile("s_waitcnt lgkmcnt(0)" ::: "memory"); SBAR();
            if (n < 4) {
#pragma unroll
                for (int i = 0; i < 4; ++i) __builtin_amdgcn_global_load_lds((const unsigned*)((const GAS char*)vb + toff[i]), (LAS unsigned*)(vbuf + i * 1024), 16, 0, 0); }
#pragma unroll
            for (int d0 = 0; d0 < 4; ++d0) {
                oT[d0] = __builtin_amdgcn_mfma_f32_32x32x16_fp8_fp8(vf[d0][0], pa0, oT[d0], 0, 0, 0);
                oT[d0] = __builtin_amdgcn_mfma_f32_32x32x16_fp8_fp8(vf[d0][1], pa1, oT[d0], 0, 0, 0); }
        }
    }
    if (HN) at_load_q(qr, nqb, ntq0, ndil, lane);
    const int tq = tq0 + dil * r32;
    v4u a0[8], a1v[8];
    if (FINAL) {
#pragma unroll
        for (int i = 0; i < 8; ++i) { const int row = 4 * i + rr0, c = cs ^ (row & 15); const size_t off = (size_t)(tq0 + dil * row) * 128 + 8 * c;
            a0[i] = __builtin_nontemporal_load((const GAS v4u*)(part0 + off)); a1v[i] = __builtin_nontemporal_load((const GAS v4u*)(part1 + off)); } }
    float osc, c1 = 0.f, c2 = 0.f;
    if (!FINAL) { osc = 1.0f / l_run; if (hi == 0) *(GAS f32x2*)(ml + (size_t)tq * 2) = (f32x2){m_run, l_run}; }
    else {
        const f32x2 s1 = st1, s2 = st2;
        const float M = fmaxf(fmaxf(s1.x, s2.x), m_run);
        const float a1 = __builtin_amdgcn_exp2f(s1.x - M) * s1.y, a2 = __builtin_amdgcn_exp2f(s2.x - M) * s2.y, a3 = __builtin_amdgcn_exp2f(m_run - M);
        const float inv = 1.0f / (a1 + a2 + a3 * l_run);
        c1 = a1 * inv; c2 = a2 * inv; osc = a3 * inv;
    }
    {
        LAS unsigned char* wrow = vbuf + r32 * 256 + hi * 8; const int qx = r32 & 15;
#pragma unroll
        for (int d0 = 0; d0 < 4; ++d0)
#pragma unroll
            for (int g4 = 0; g4 < 4; ++g4) { u32x2 w; w.x = cvtpk(oT[d0][4 * g4] * osc, oT[d0][4 * g4 + 1] * osc); w.y = cvtpk(oT[d0][4 * g4 + 2] * osc, oT[d0][4 * g4 + 3] * osc);
                *(LAS u32x2*)(wrow + (((4 * d0 + g4) ^ qx) << 4)) = w; }
    }
    asm volatile("s_waitcnt lgkmcnt(0)" ::: "memory"); SBAR();
    if (!FINAL) {
#pragma unroll
        for (int i = 0; i < 8; ++i) a0[i] = *(const LAS v4u*)(vbuf + (4 * i + rr0) * 256 + cs * 16);
#pragma unroll
        for (int i = 0; i < 8; ++i) { const int row = 4 * i + rr0, c = cs ^ (row & 15);
            *(GAS v4u*)(part + (size_t)(tq0 + dil * row) * 128 + 8 * c) = a0[i]; }
    } else {
#pragma unroll
        for (int i = 0; i < 8; ++i) { const int row = 4 * i + rr0, c = cs ^ (row & 15);
            const float w1 = __shfl(c1, row), w2 = __shfl(c2, row);
            const v4u o = *(const LAS v4u*)(vbuf + row * 256 + cs * 16);
            float f8[8];
#define AT_MIX(F, J) do { f8[2 * J] = w1 * bf2f(a0[i].F & 0xffffu) + w2 * bf2f(a1v[i].F & 0xffffu) + bf2f(o.F & 0xffffu); \
                f8[2 * J + 1] = w1 * bf2f(a0[i].F >> 16) + w2 * bf2f(a1v[i].F >> 16) + bf2f(o.F >> 16); } while (0)
            AT_MIX(x, 0); AT_MIX(y, 1); AT_MIX(z, 2); AT_MIX(w, 3);
#undef AT_MIX
            u32x2 r8; r8.x = pg8::pk_fp8x4((f32x4){f8[0], f8[1], f8[2], f8[3]}); r8.y = pg8::pk_fp8x4((f32x4){f8[4], f8[5], f8[6], f8[7]});
            *(GAS u32x2*)((GAS unsigned char*)yout + (size_t)(tq0 + dil * row) * 3072 + 8 * c) = r8; }
    }
    asm volatile("s_waitcnt lgkmcnt(0)" ::: "memory"); SBAR();
    if (HN) at_dma_v(vbuf, nvb, ntq0, ndil, 0, lane);
}

struct Args { const float* in[9]; float* out; unsigned char* ws; };

__global__ void __launch_bounds__(NWAVES * 64, 2) mk_fwd(Args args) {
    extern __shared__ __attribute__((aligned(16))) unsigned char lds_raw[];
    LAS unsigned char* lds = (LAS unsigned char*)lds_raw;
    volatile LAS unsigned* MISC = (volatile LAS unsigned*)(lds + MISC_OFF);
    const int tid = threadIdx.x, lane = tid & 63, wave = __builtin_amdgcn_readfirstlane(tid >> 6);
    const int G = gridDim.x, gw = blockIdx.x * NWAVES + wave, NGW = G * NWAVES;
    unsigned char* ws = args.ws;
    const float* x = args.in[0]; const float* g_mix = args.in[1]; const float* w_in = args.in[2]; const float* w_f = args.in[3];
    const float* w_out = args.in[4]; const float* g_mlp = args.in[5]; const float* w_up = args.in[6]; const float* w_down = args.in[7]; const float* g_fin = args.in[8];
    float* out = args.out;
    float* ssq1 = (float*)(ws + WS_SSQ1); float* ssq2 = (float*)(ws + WS_SSQ2); float* inv0 = (float*)(ws + WS_INV0);
    bf16_t* abt = (bf16_t*)(ws + WS_ABT);
    bf16_t* wint = (bf16_t*)(ws + WS_WINT); bf16_t* wo = (bf16_t*)(ws + WS_WO); bf16_t* wup = (bf16_t*)(ws + WS_WUP); bf16_t* wd = (bf16_t*)(ws + WS_WD);
    bf16_t* h1b = (bf16_t*)(ws + WS_H1B); bf16_t* xb = (bf16_t*)(ws + WS_XB); bf16_t* y = (bf16_t*)(ws + WS_Y);
    bf16_t* qkv = (bf16_t*)(ws + WS_Q); bf16_t* zt = (bf16_t*)(ws + WS_ZT); bf16_t* trig2 = (bf16_t*)(ws + WS_TRIG2); bf16_t* abuf = (bf16_t*)(ws + WS_A);

    for (int u = tid; u < (LDS_BYTES - LDSCTL_OFF) / 4; u += NWAVES * 64) ((LAS unsigned*)(lds + LDSCTL_OFF))[u] = 0u;
    __syncthreads();
    XcdBarrier bar = xcd_barrier_post((unsigned*)(ws + WS_CTL) + CW_BAR, MISC + 8);

    {
        LAS float* scr = (LAS float*)(lds + wave * 16384);
        for (int m = gw; m < T; m += NGW) {
            const GAS f32x4* xr = (const GAS f32x4*)(x + (size_t)m * DM) + lane; f32x4 v[8]; float s = 0.f;
#pragma unroll
            for (int j = 0; j < 8; ++j) { v[j] = __builtin_nontemporal_load(&xr[64 * j]); s += (v[j].x * v[j].x + v[j].y * v[j].y) + (v[j].z * v[j].z + v[j].w * v[j].w); }
            s = wave_sum(s);
            if (lane == 0) { const float iv = 1.0f / sqrtf(s * (1.0f / DM) + EPS); inv0[m] = iv; }
            GAS unsigned long long* o8 = (GAS unsigned long long*)(xb + (size_t)m * DM) + lane;
#pragma unroll
            for (int j = 0; j < 8; ++j) o8[64 * j] = (unsigned long long)pk2(v[j].x, v[j].y) | ((unsigned long long)pk2(v[j].z, v[j].w) << 32);
        }
        {
            LAS unsigned* ctu = (LAS unsigned*)(scr + 2304); LAS unsigned* stu = (LAS unsigned*)(scr + 2560);
            for (int j = lane; j < 256; j += 64) { ctu[j] = f2bf(cospif((float)j / 128.0f)); stu[j] = f2bf(sinpif((float)j / 128.0f)); }
            LDS_WAIT();
            typedef float f32x4v __attribute__((ext_vector_type(4)));
            for (int it = gw; it < 4 * 16 * 16; it += NGW) {
                const int cb = it & 15, ebk = (it >> 4) & 15, g = it >> 8, i16 = lane & 15, kg = lane >> 4, c = cb * 16 + i16;
                const float* wcol = w_f + (size_t)g * 65536 + ebk * 16 + i16;
                f32x4v dc = {0.f, 0.f, 0.f, 0.f}, ds = {0.f, 0.f, 0.f, 0.f};
#pragma unroll 2
                for (int ks = 0; ks < 8; ++ks) { const int k0 = 32 * ks + 8 * kg;
                    float wv[8];
#pragma unroll
                    for (int j = 0; j < 8; ++j) wv[j] = wcol[(size_t)(k0 + j) * 256];
                    v4u bw, ac, as;
                    bw.x = pg8::cvt_pk_bf16(wv[0], wv[1]); bw.y = pg8::cvt_pk_bf16(wv[2], wv[3]); bw.z = pg8::cvt_pk_bf16(wv[4], wv[5]); bw.w = pg8::cvt_pk_bf16(wv[6], wv[7]);
#define ABT_PH(J) ((c * (k0 + (J))) & 255)
                    ac.x = ctu[ABT_PH(0)] | (ctu[ABT_PH(1)] << 16); ac.y = ctu[ABT_PH(2)] | (ctu[ABT_PH(3)] << 16); ac.z = ctu[ABT_PH(4)] | (ctu[ABT_PH(5)] << 16); ac.w = ctu[ABT_PH(6)] | (ctu[ABT_PH(7)] << 16);
                    as.x = stu[ABT_PH(0)] | (stu[ABT_PH(1)] << 16); as.y = stu[ABT_PH(2)] | (stu[ABT_PH(3)] << 16); as.z = stu[ABT_PH(4)] | (stu[ABT_PH(5)] << 16); as.w = stu[ABT_PH(6)] | (stu[ABT_PH(7)] << 16);
#undef ABT_PH
                    dc = __builtin_amdgcn_mfma_f32_16x16x32_bf16(__builtin_bit_cast(bf16x8, ac), __builtin_bit_cast(bf16x8, bw), dc, 0, 0, 0);
                    ds = __builtin_amdgcn_mfma_f32_16x16x32_bf16(__builtin_bit_cast(bf16x8, as), __builtin_bit_cast(bf16x8, bw), ds, 0, 0, 0); }
                bf16_t* o = abt + ((size_t)g * 512 + 2 * (ebk * 16 + i16)) * 256 + cb * 16 + 4 * kg;
                *(GAS u32x2*)o = (u32x2){pg8::cvt_pk_bf16(dc[0], dc[1]), pg8::cvt_pk_bf16(dc[2], dc[3])};
                *(GAS u32x2*)(o + 256) = (u32x2){pg8::cvt_pk_bf16(ds[0], ds[1]), pg8::cvt_pk_bf16(ds[2], ds[3])};
            }
        }
        for (int it = gw * 64 + lane; it < 256 * 512 / 8; it += NGW * 64) {
            const int k0 = (it & 63) * 8, s2p = it >> 6; float v[8];
#pragma unroll
            for (int e = 0; e < 8; ++e) { const int k = k0 + e, s2 = k >> 1; const float a2 = (float)((s2 * s2p) & 255) * (1.0f / 128.0f);
                v[e] = ((k & 1) ? sinpif(a2) : cospif(a2)) * (1.0f / 1024.0f); }
            v4u o; o.x = pk2(v[0], v[1]); o.y = pk2(v[2], v[3]); o.z = pk2(v[4], v[5]); o.w = pk2(v[6], v[7]);
            *(GAS v4u*)(trig2 + (size_t)it * 8) = o;
        }
        {
            constexpr int I_QKV = (2048 / 64) * (3072 / 32), I_U = (2048 / 64) * (1024 / 32), I_O = (2048 / 64) * (2048 / 32), I_UP = (2048 / 64) * (8192 / 32), I_D = (8192 / 64) * (2048 / 32);
            constexpr int NITEMS = I_QKV + I_U + I_O + I_UP + I_D;
            for (int it = gw; it < NITEMS; it += NGW) {
                int r = it;
                if (r < I_QKV) { p0_transpose_item(w_in, 4096, 1024, 2048, 3072, g_mix, wint, scr, r, lane); continue; } r -= I_QKV;
                if (r < I_U) { p0_transpose_item(w_in, 4096, 0, 2048, 1024, g_mix, wint + (size_t)3072 * 2048, scr, r, lane); continue; } r -= I_U;
                if (r < I_O) { p0_transpose_item_wo(w_out, wo, scr, r, lane); continue; } r -= I_O;
                if (r < I_UP) { p0_transpose_item(w_up, 8192, 0, 2048, 8192, g_mlp, wup, scr, r, lane); continue; } r -= I_UP;
                p0_transpose_item(w_down, 2048, 0, 8192, 2048, nullptr, wd, scr, r, lane);
            }
        }
    }
    xcd_barrier(bar, wave);

    {
        pg8::AddrStd g{xb, wint, 2048, 2048, 30, 0u}; pg8::StaticOrder S; S.init(T, 4096, G, (int)blockIdx.x, WGM_Q);
        pg8::EpiB<0, 1, false, true> E{qkv, 1024, inv0, nullptr, 1024, (size_t)T * 1024, QSCALE};
        pg8::gemm_phase<pg8::EpiB<0, 1, false, true>, pg8::StaticOrder, pg8::AddrStd, true>(lds, 2048, g, S, E, wave);
    }
    xcd_barrier(bar, wave);
    {
        pg8::AddrF1u g{abt, qkv + (size_t)3 * T * 1024}; pg8::StaticOrder S; S.init(2048, T, G, (int)blockIdx.x, WGM_F);
        pg8::EpiDft1 E{zt, lds};
        const int nu = (S.nwg - (int)blockIdx.x + G - 1) / G;
#pragma unroll 1
        for (int i = 0; i < nu; ++i) { pg8::OneUnit o; (void)S.next(i, o.u);
            pg8::gemm_phase<pg8::EpiDft1, pg8::OneUnit, pg8::AddrF1u, true>(lds, 256, g, o, E, wave); }
    }

    bf16_t* const part0 = (bf16_t*)out; bf16_t* const part1 = part0 + (size_t)T * 1024;
    float* const mlb0 = (float*)((unsigned char*)out + 64 * MiB); float* const mlb1 = mlb0 + (size_t)T * NH * 2;
    const int vwave = (G % 8 == 0) ? (int)(((blockIdx.x & 7) * (G >> 3) + (blockIdx.x >> 3)) * NWAVES + wave) : gw;
    {
        LAS unsigned char* wl = lds + wave * 16384;
        int lna = (int)lane_id_fresh(); asm volatile("" : "+v"(lna));
        constexpr int NU = NB * NH * 256;
#define AT_DEC_AB(U_, QP, KP, VP, TQ, DL, SL, PP, MP) do { const int pr_ = (U_) >> 8, sl_ = (U_) & 255, h_ = pr_ & 7; const size_t hb_ = (size_t)(pr_ >> 3) * SEQ * 1024 + h_ * 128; \
            const size_t hm_ = (size_t)pr_ * SEQ * 128; QP = qkv + hm_; KP = qkv + (size_t)T * 1024 + hm_ / 2; VP = qkv + (size_t)2 * T * 1024 + hm_ / 2; const float s2_ = exp2f(-(float)(h_ + 1)) * LOG2E; \
            if (sl_ < 128) { DL = 16; TQ = 512 * (sl_ >> 4) + (sl_ & 15); PP = part0 + hm_; MP = mlb0 + (size_t)pr_ * SEQ * 2; } \
            else { const int s_ = sl_ - 128; DL = 4; TQ = 128 * (s_ >> 2) + (s_ & 3); PP = part1 + hm_; MP = mlb1 + (size_t)pr_ * SEQ * 2; } SL = s2_ * (float)DL; } while (0)
        int U = vwave;
        if (U < NU) {
            const bf16_t *cq, *ck, *cv, *nq, *nk, *nv; bf16_t *cp, *np_; float *cm, *nm; int ctq, cdl, ntq = 0, ndl = 1; float csl, nsl = 0.f;
            AT_DEC_AB(U, cq, ck, cv, ctq, cdl, csl, cp, cm);
            nq = cq; nk = ck; nv = cv; np_ = cp; nm = cm;
            bf16x8 qr[8];
            at_unit_prologue(wl, qr, cq, ck, cv, ctq, cdl, lna);
#pragma unroll 1
            for (;;) {
                const int Un = U + NGW; const bool hn = Un < NU;
                if (hn) AT_DEC_AB(Un, nq, nk, nv, ntq, ndl, nsl, np_, nm);
                attn_unit(false, hn, wl, cq, ck, cv, ctq, cdl, csl, qr, nq, nk, nv, ntq, ndl, cp, cm, nullptr, nullptr, nullptr, nullptr, nullptr, lna);
                if (!hn) break;
                U = Un; cq = nq; ck = nk; cv = nv; ctq = ntq; cdl = ndl; csl = nsl; cp = np_; cm = nm;
            }
        }
#undef AT_DEC_AB
    }
    xcd_barrier(bar, wave);

    {
        LAS unsigned char* wl = lds + wave * 16384;
        int lna = (int)lane_id_fresh(); asm volatile("" : "+v"(lna));
        constexpr int NU = NB * NH * 128;
#define AT_DEC_C(U_, QP, KP, VP, TQ, SL, P0, P1, M0, M1, YP) do { const int pr_ = (U_) >> 7, h_ = pr_ & 7, b_ = pr_ >> 3; const size_t hb_ = (size_t)b_ * SEQ * 1024 + h_ * 128; \
            const size_t hm_ = (size_t)pr_ * SEQ * 128; QP = qkv + hm_; KP = qkv + (size_t)T * 1024 + hm_ / 2; VP = qkv + (size_t)2 * T * 1024 + hm_ / 2; SL = exp2f(-(float)(h_ + 1)) * LOG2E; TQ = 32 * ((U_) & 127); \
            P0 = part0 + hm_; P1 = part1 + hm_; M0 = mlb0 + (size_t)pr_ * SEQ * 2; M1 = mlb1 + (size_t)pr_ * SEQ * 2; YP = (bf16_t*)((unsigned char*)y + (size_t)b_ * SEQ * 3072 + 2048 + h_ * 128); } while (0)
        int U = vwave;
        if (U < NU) {
            const bf16_t *cq, *ck, *cv, *nq, *nk, *nv, *c0, *c1, *n0, *n1; const float *cm0, *cm1, *nm0, *nm1; bf16_t *cy, *ny; int ctq, ntq = 0; float csl, nsl = 0.f;
            AT_DEC_C(U, cq, ck, cv, ctq, csl, c0, c1, cm0, cm1, cy);
            nq = cq; nk = ck; nv = cv; n0 = c0; n1 = c1; nm0 = cm0; nm1 = cm1; ny = cy;
            bf16x8 qr[8];
            at_unit_prologue(wl, qr, cq, ck, cv, ctq, 1, lna);
#pragma unroll 1
            for (;;) {
                const int Un = U + NGW; const bool hn = Un < NU;
                if (hn) AT_DEC_C(Un, nq, nk, nv, ntq, nsl, n0, n1, nm0, nm1, ny);
                attn_unit(true, hn, wl, cq, ck, cv, ctq, 1, csl, qr, nq, nk, nv, ntq, 1, nullptr, nullptr, c0, c1, cm0, cm1, cy, lna);
                if (!hn) break;
                U = Un; cq = nq; ck = nk; cv = nv; ctq = ntq; csl = nsl; c0 = n0; c1 = n1; cm0 = nm0; cm1 = nm1; cy = ny;
            }
        }
#undef AT_DEC_C
        asm volatile("s_waitcnt vmcnt(0)" ::: "memory");
        __syncthreads();
    }

    {
        pg8::AddrF2 g{trig2, zt}; pg8::StaticOrder S; S.init(64 * 256, 1024, G, (int)blockIdx.x);
        pg8::EpiY E{y, 1536};
        pg8::gemm_phase<pg8::EpiY, pg8::StaticOrder, pg8::AddrF2, true>(lds, 512, g, S, E, wave);
    }
    xcd_barrier(bar, wave);

    {
        pg8::AddrStd g{y, wo, 1536, 1536, 30, 0u}; pg8::StaticOrder S; S.init(T, 2048, G, (int)blockIdx.x, WGM_O);
        pg8::EpiResXb E{xb, h1b, ssq1, 2048, 1.0f / 32.0f};
        pg8::gemm_phase<pg8::EpiResXb, pg8::StaticOrder, pg8::AddrStd, true, 16>(lds, 1536, g, S, E, wave);
    }
    xcd_barrier(bar, wave);

    const bool fuse7 = G >= (T / 2 / 256) * (DM / 256);
    for (int half = 0; half < 2; ++half) {
        const size_t roff = (size_t)half * (T / 2);
        bf16_t* const ab = (fuse7 && half) ? (bf16_t*)(ws + WS_XB) : abuf;
        {
            pg8::AddrStd g{h1b + roff * DM, wup, 2048, 2048, 30, 0u}; pg8::StaticOrder S; S.init(T / 2, DFF, G, (int)blockIdx.x, WGM_U);
            pg8::EpiB<2, 2, false> E{ab, DFF, ssq1 + roff, nullptr, 0, 0, 1.f};
            pg8::gemm_phase<pg8::EpiB<2, 2, false>, pg8::StaticOrder, pg8::AddrStd, true>(lds, 2048, g, S, E, wave);
        }
        xcd_barrier(bar, wave);
        if (fuse7) {
            pg8::AddrStd g{ab, wd, DFF, DFF, 30, 0u}; pg8::StaticOrder S; S.init(T / 2, 2048, G, (int)blockIdx.x, WGM_D);
            pg8::EpiResOut E{h1b + roff * DM, ssq2 + roff, out + roff * DM, g_fin, (unsigned*)(ws + WS_CTL) + CW_EXCH + half * 1024, (unsigned*)(ws + WS_CTL) + CW_BAR + XB_TMO, 2048, 32u};
            pg8::gemm_phase<pg8::EpiResOut, pg8::StaticOrder, pg8::AddrStd, true>(lds, DFF, g, S, E, wave);
        } else {
            pg8::AddrStd g{abuf, wd, DFF, DFF, 30, 0u}; pg8::StaticOrder S; S.init(T / 2, 2048, G, (int)blockIdx.x, WGM_D);
            pg8::EpiResB E{h1b + roff * DM, ssq2 + roff, 2048};
            pg8::gemm_phase<pg8::EpiResB, pg8::StaticOrder, pg8::AddrStd, true>(lds, DFF, g, S, E, wave);
            xcd_barrier(bar, wave);
        }
    }
    if (fuse7) return;

    const int lane7 = (int)lane_id_fresh();
    for (int m = gw; m < T; m += NGW) {
        const GAS v4u* hr = (const GAS v4u*)(h1b + (size_t)m * DM) + lane7; GAS f32x4* xr = (GAS f32x4*)(out + (size_t)m * DM) + 2 * lane7; const GAS f32x4* gr = (const GAS f32x4*)g_fin + 2 * lane7;
        const float inv = 1.0f / sqrtf(ssq2[m] * (1.0f / DM) + EPS);
#pragma unroll
        for (int j = 0; j < 4; ++j) { const v4u b = __builtin_nontemporal_load(&hr[64 * j]); const f32x4 g0 = gr[128 * j], g1 = gr[128 * j + 1];
            __builtin_nontemporal_store((f32x4){bf2f(b.x & 0xffffu) * inv * g0.x, bf2f(b.x >> 16) * inv * g0.y, bf2f(b.y & 0xffffu) * inv * g0.z, bf2f(b.y >> 16) * inv * g0.w}, &xr[128 * j]);
            __builtin_nontemporal_store((f32x4){bf2f(b.z & 0xffffu) * inv * g1.x, bf2f(b.z >> 16) * inv * g1.y, bf2f(b.w & 0xffffu) * inv * g1.z, bf2f(b.w >> 16) * inv * g1.w}, &xr[128 * j + 1]); }
    }
}

extern "C" void kernel_launch(void* const* d_in, const int* in_sizes, int n_in, void* d_out, int out_size, void* d_ws, size_t ws_size, hipStream_t stream) {
    static int grid = 0;
    if (grid == 0) {
        if (n_in != 9 || in_sizes[0] != T * DM || out_size != T * DM || ws_size < WS_END) {
            fprintf(stderr, "kernel_launch: unexpected shapes: n_in %d in0 %d out %d ws %zu (need >= %zu)\n", n_in, n_in > 0 ? in_sizes[0] : -1, out_size, ws_size, (size_t)WS_END);
            grid = -1; return; }
        int dev = 0, cus = 0, per_cu = 0;
        if (hipGetDevice(&dev) != hipSuccess || hipDeviceGetAttribute(&cus, hipDeviceAttributeMultiprocessorCount, dev) != hipSuccess) { fprintf(stderr, "kernel_launch: device query failed\n"); grid = -1; return; }
        if (hipFuncSetAttribute((const void*)mk_fwd, hipFuncAttributeMaxDynamicSharedMemorySize, LDS_BYTES) != hipSuccess) { fprintf(stderr, "kernel_launch: hipFuncSetAttribute failed\n"); grid = -1; return; }
        if (hipOccupancyMaxActiveBlocksPerMultiprocessor(&per_cu, (const void*)mk_fwd, NWAVES * 64, LDS_BYTES) != hipSuccess || per_cu < 1) {
            fprintf(stderr, "kernel_launch: occupancy query reports %d workgroups per CU; need 1\n", per_cu); (void)hipGetLastError(); grid = -1; return; }
        grid = cus;
    }
    if (grid < 0) return;
    if (hipMemsetAsync((char*)d_ws + WS_CTL, 0, CTL_ZERO_BYTES, stream) != hipSuccess) { fprintf(stderr, "kernel_launch: hipMemsetAsync failed\n"); return; }
    Args a{};
    for (int i = 0; i < 9; ++i) a.in[i] = (const float*)d_in[i];
    a.out = (float*)d_out; a.ws = (unsigned char*)d_ws;
    hipLaunchKernelGGL(mk_fwd, dim3(grid), dim3(NWAVES * 64), LDS_BYTES, stream, a);
    const hipError_t le = hipPeekAtLastError();
    if (le != hipSuccess) fprintf(stderr, "kernel_launch: launch failed: %s\n", hipGetErrorName(le));
}
```

```cpp
#include <hip/hip_runtime.h>
#include <cstdio>
#include <cstdint>

constexpr int NB = 4, SEQ = 4096, DM = 2048, T = NB * SEQ, DFF = 8192;
constexpr int NH = 8;
constexpr float EPS = 1e-6f;
constexpr float LOG2E = 1.4426950408889634f;
constexpr float QSCALE = 0.08838834764831845f * LOG2E;

namespace pg8 {
#define PG8_LAS __attribute__((address_space(3)))
#define PG8_GAS __attribute__((address_space(1)))
__device__ __forceinline__ unsigned lane_id_fresh() { unsigned m = ~0u; asm volatile("" : "+s"(m)); return __builtin_amdgcn_mbcnt_hi(m, __builtin_amdgcn_mbcnt_lo(m, 0u)); }
typedef unsigned short bf16_t;
typedef short bf16x8 __attribute__((ext_vector_type(8)));
typedef float f32x4 __attribute__((ext_vector_type(4)));
typedef unsigned u32x4 __attribute__((ext_vector_type(4)));
typedef unsigned u32x2 __attribute__((ext_vector_type(2)));
constexpr int BM = 256, BK = 64, HALF = 128, HTB = HALF * BK * 2  , STAGE_BYTES = 8 * HTB, NXCD = 8, WGM = 4;

__host__ __device__ __forceinline__ int lds_byte(int r, int c) { const int st = (r >> 4) * 2 + (c >> 5), rr = r & 15, cc = c & 31, ob = rr * 64 + cc * 2; return st * 1024 + (ob ^ (((ob >> 9) & 1) << 5)); }
__host__ __device__ __forceinline__ void stage_rc(int b, int& R, int& C) { const int st = b / 1024, sb = b % 1024, swz = sb ^ (((sb >> 9) & 1) << 5); R = (st >> 1) * 16 + swz / 64; C = (st & 1) * 32 + (swz % 64) / 2; }
__host__ __device__ __forceinline__ int perm32(int rho) { const int n = rho >> 4, i = rho & 15; return 8 * (i >> 2) + 4 * n + (i & 3); }

struct Unit { int pm, pn; };
struct AddrStd {
    const bf16_t* A; const bf16_t* Bt; int lda, ldb, gshift; unsigned goff;
    __device__ __forceinline__ unsigned voffA(int R, int C) const { return (unsigned)(R * lda + C) * 2u; }
    __device__ __forceinline__ unsigned voffB(int R, int C) const { return (unsigned)(R * ldb + C) * 2u; }
    __device__ __forceinline__ size_t hA() const { return (size_t)HALF * lda * 2; }
    __device__ __forceinline__ size_t hB() const { return (size_t)HALF * ldb * 2; }
    __device__ __forceinline__ const char* a(const Unit& u) const { return (const char*)A + (size_t)u.pm * 2 * hA(); }
    __device__ __forceinline__ const char* b(const Unit& u) const { return (const char*)Bt + (size_t)u.pn * 2 * hB() + (size_t)(u.pm >> gshift) * goff; }
};
struct AddrF1u {
    const bf16_t* A; const bf16_t* Bt;
    __device__ __forceinline__ unsigned voffA(int R, int C) const { return (unsigned)(R * 256 + C) * 2u; }
    __device__ __forceinline__ unsigned voffB(int R, int C) const { return (unsigned)((256 * (R & 15) + (R >> 4)) * 1024 + C) * 2u; }
    __device__ __forceinline__ size_t hA() const { return (size_t)HALF * 256 * 2; }
    __device__ __forceinline__ size_t hB() const { return (size_t)8 * 1024 * 2; }
    __device__ __forceinline__ const char* a(const Unit& u) const { return (const char*)A + (size_t)u.pm * 2 * hA(); }
    __device__ __forceinline__ const char* b(const Unit& u) const { return (const char*)Bt + (size_t)((u.pn >> 4) * 4096 + (u.pn & 15) * 16) * 1024 * 2 + (size_t)(u.pm >> 1) * 512; }
};
struct AddrF2 {
    const bf16_t* A; const bf16_t* Bt;
    __device__ __forceinline__ unsigned voffA(int R, int C) const { return (unsigned)(R * 512 + C) * 2u; }
    __device__ __forceinline__ unsigned voffB(int R, int C) const { return (unsigned)(R * 8192 + C) * 2u; }
    __device__ __forceinline__ size_t hA() const { return (size_t)HALF * 512 * 2; }
    __device__ __forceinline__ size_t hB() const { return (size_t)HALF * 8192 * 2; }
    __device__ __forceinline__ const char* a(const Unit&) const { return (const char*)A; }
    __device__ __forceinline__ const char* b(const Unit& u) const { return (const char*)Bt + ((size_t)(((u.pm >> 4) * 1024 + u.pn * 256) * 16 + (u.pm & 15)) * 512) * 2; }
};

struct StaticOrder {
    int nM, nN, nwg, G, c, wgm;
    __host__ __device__ void init(int M, int N, int G_, int c_, int wgm_ = WGM) { nM = M / BM; nN = N / BM; nwg = nM * nN; G = G_; c = c_; wgm = wgm_; }
    __host__ __device__ bool next(int i, Unit& u) const {
        const long L = (long)i * G + c; if (L >= nwg) return false;
        int wgid = (int)L; { const int q = nwg / NXCD, r = nwg % NXCD, xcd = wgid % NXCD, off = wgid / NXCD; wgid = (xcd < r ? xcd * (q + 1) : r * (q + 1) + (xcd - r) * q) + off; }
        const int nig = wgm * nN, gid = wgid / nig, fm = gid * wgm, gsz = (nM - fm) < wgm ? (nM - fm) : wgm;
        u.pm = fm + ((wgid % nig) % gsz); u.pn = (wgid % nig) / gsz; return true;
    }
    __device__ __forceinline__ void a_ready(const Unit&) const {}
    __device__ __forceinline__ void done(const Unit&) const {}
};

__device__ __forceinline__ unsigned cvt_pk_bf16(float lo, float hi) { unsigned r; asm volatile("v_cvt_pk_bf16_f32 %0, %1, %2" : "=v"(r) : "v"(lo), "v"(hi)); return r; }

__device__ __forceinline__ unsigned pk_fp8x4(const f32x4 v) { int r = __builtin_amdgcn_cvt_pk_fp8_f32(v[0], v[1], 0, false); r = __builtin_amdgcn_cvt_pk_fp8_f32(v[2], v[3], r, true); return (unsigned)r; }
template <int ACT, int RS, bool CS, bool HM = false> struct EpiB {
    static constexpr bool PERM = true, AFTER_DRAIN = false;
    bf16_t* O; int ldc; const float* rs; const float* cs; int split_cols; size_t split_stride; float scale0;
    __device__ __forceinline__ void operator()(const f32x4 (&acc)[2][2][4][2], const Unit& u, int wr, int wc, int fr, int fq) const {
        { int l_ = (int)lane_id_fresh(); asm volatile("" : "+v"(l_)); fr = l_ & 15; fq = l_ >> 4; }
        const int row0 = u.pm * BM + wr * 64 + fr; int colt = u.pn * BM; bf16_t* base = O;
        float sc = 1.f; bool hm = false, k8 = false; if (split_cols) { const int t = colt / split_cols; base += (size_t)t * split_stride; colt -= t * split_cols; if (t == 0) sc = scale0; hm = HM && t < 3; k8 = HM && (t == 1 || t == 2); }
        const int col0 = colt + wc * 32 + 8 * fq, gcol0 = u.pn * BM + wc * 32 + 8 * fq;
        const size_t bstep = hm ? (size_t)4096 * 128 : (size_t)HALF;
        f32x4 cv[2][2];
#pragma unroll
        for (int bj = 0; bj < 2; ++bj)
#pragma unroll
            for (int n = 0; n < 2; ++n) cv[bj][n] = CS ? *(const f32x4*)(cs + gcol0 + bj * HALF + 4 * n) : (f32x4){1.f, 1.f, 1.f, 1.f};
        float rsv[2][4];
#pragma unroll
        for (int ai = 0; ai < 2; ++ai)
#pragma unroll
            for (int m = 0; m < 4; ++m) rsv[ai][m] = RS ? rs[row0 + ai * HALF + m * 16] : 1.0f;
#pragma unroll
        for (int ai = 0; ai < 2; ++ai)
#pragma unroll
            for (int m = 0; m < 4; ++m) { const int r = row0 + ai * HALF + m * 16;
                bf16_t* rowp = hm ? base + ((size_t)((r >> 12) * 8 + (colt >> 7)) * 4096 + (r & 4095)) * 128 + wc * 32 + 8 * fq : base + (size_t)r * ldc + col0;
                float rv = sc; if (RS == 1) rv *= rsv[ai][m]; if (RS == 2) rv *= __builtin_amdgcn_rsqf(rsv[ai][m] * (1.0f / DM) + EPS);
#pragma unroll
                for (int bj = 0; bj < 2; ++bj) { f32x4 v0 = acc[ai][bj][m][0] * rv, v1 = acc[ai][bj][m][1] * rv;
                    if (CS) { v0 = v0 * cv[bj][0]; v1 = v1 * cv[bj][1]; }
                    if (ACT == 2) {
#pragma unroll
                        for (int e = 0; e < 4; ++e) { float a = v0[e] > 0.f ? v0[e] : 0.f, b = v1[e] > 0.f ? v1[e] : 0.f; v0[e] = a * a; v1[e] = b * b; } }
                    if (k8) {
                        u32x2 w8; w8.x = pk_fp8x4(v0); w8.y = pk_fp8x4(v1);
                        *(u32x2*)((unsigned char*)base + ((size_t)((r >> 12) * 8 + (colt >> 7) + bj) * 4096 + (r & 4095)) * 128 + wc * 32 + 8 * fq) = w8;
                    } else {
                    u32x4 w; w.x = cvt_pk_bf16(v0[0], v0[1]); w.y = cvt_pk_bf16(v0[2], v0[3]); w.z = cvt_pk_bf16(v1[0], v1[1]); w.w = cvt_pk_bf16(v1[2], v1[3]);
                    *(u32x4*)(rowp + bj * bstep) = w; } } }
    }
};
struct EpiResXb {
    static constexpr bool PERM = true, AFTER_DRAIN = false;
    const bf16_t* xb; bf16_t* outb; float* ssq; int ldc; float asc;
    __device__ __forceinline__ void operator()(const f32x4 (&acc)[2][2][4][2], const Unit& u, int wr, int wc, int fr, int fq) const {
        { int l_ = (int)lane_id_fresh(); asm volatile("" : "+v"(l_)); fr = l_ & 15; fq = l_ >> 4; }
        const int row0 = u.pm * BM + wr * 64 + fr, col0 = u.pn * BM + wc * 32 + 8 * fq;
        u32x4 bv[2][4][2];
#pragma unroll
        for (int ai = 0; ai < 2; ++ai)
#pragma unroll
            for (int m = 0; m < 4; ++m) { const size_t off = (size_t)(row0 + ai * HALF + m * 16) * ldc + col0;
#pragma unroll
                for (int bj = 0; bj < 2; ++bj) bv[ai][m][bj] = __builtin_nontemporal_load((const u32x4*)(xb + off + bj * HALF)); }
#pragma unroll
        for (int ai = 0; ai < 2; ++ai)
#pragma unroll
            for (int m = 0; m < 4; ++m) { const int r = row0 + ai * HALF + m * 16; const size_t off = (size_t)r * ldc + col0; float s = 0.f;
#pragma unroll
                for (int bj = 0; bj < 2; ++bj) { const u32x4 b = bv[ai][m][bj];
                    f32x4 o0, o1;
                    o0[0] = __builtin_fmaf(acc[ai][bj][m][0][0], asc, __builtin_bit_cast(float, b.x << 16)); o0[1] = __builtin_fmaf(acc[ai][bj][m][0][1], asc, __builtin_bit_cast(float, b.x & 0xffff0000u));
                    o0[2] = __builtin_fmaf(acc[ai][bj][m][0][2], asc, __builtin_bit_cast(float, b.y << 16)); o0[3] = __builtin_fmaf(acc[ai][bj][m][0][3], asc, __builtin_bit_cast(float, b.y & 0xffff0000u));
                    o1[0] = __builtin_fmaf(acc[ai][bj][m][1][0], asc, __builtin_bit_cast(float, b.z << 16)); o1[1] = __builtin_fmaf(acc[ai][bj][m][1][1], asc, __builtin_bit_cast(float, b.z & 0xffff0000u));
                    o1[2] = __builtin_fmaf(acc[ai][bj][m][1][2], asc, __builtin_bit_cast(float, b.w << 16)); o1[3] = __builtin_fmaf(acc[ai][bj][m][1][3], asc, __builtin_bit_cast(float, b.w & 0xffff0000u));
                    s += ((o0[0] * o0[0] + o0[1] * o0[1]) + (o0[2] * o0[2] + o0[3] * o0[3])) + ((o1[0] * o1[0] + o1[1] * o1[1]) + (o1[2] * o1[2] + o1[3] * o1[3]));
                    u32x4 w; w.x = cvt_pk_bf16(o0[0], o0[1]); w.y = cvt_pk_bf16(o0[2], o0[3]); w.z = cvt_pk_bf16(o1[0], o1[1]); w.w = cvt_pk_bf16(o1[2], o1[3]);
                    *(u32x4*)(outb + off + bj * HALF) = w; }
                s += __shfl_xor(s, 16); s += __shfl_xor(s, 32);
                if (fq == 0) atomicAdd(ssq + r, s); }
    }
};
struct EpiResB {
    static constexpr bool PERM = true, AFTER_DRAIN = false;
    bf16_t* hb; float* ssq; int ldc;
    __device__ __forceinline__ void operator()(const f32x4 (&acc)[2][2][4][2], const Unit& u, int wr, int wc, int fr, int fq) const {
        { int l_ = (int)lane_id_fresh(); asm volatile("" : "+v"(l_)); fr = l_ & 15; fq = l_ >> 4; }
        const int row0 = u.pm * BM + wr * 64 + fr, col0 = u.pn * BM + wc * 32 + 8 * fq;
        u32x4 bv[2][4][2];
#pragma unroll
        for (int ai = 0; ai < 2; ++ai)
#pragma unroll
            for (int m = 0; m < 4; ++m) { const size_t off = (size_t)(row0 + ai * HALF + m * 16) * ldc + col0;
#pragma unroll
                for (int bj = 0; bj < 2; ++bj) bv[ai][m][bj] = *(const u32x4*)(hb + off + bj * HALF); }
#pragma unroll
        for (int ai = 0; ai < 2; ++ai)
#pragma unroll
            for (int m = 0; m < 4; ++m) { const int r = row0 + ai * HALF + m * 16; const size_t off = (size_t)r * ldc + col0; float s = 0.f;
#pragma unroll
                for (int bj = 0; bj < 2; ++bj) { const u32x4 b = bv[ai][m][bj];
                    f32x4 o0, o1;
                    o0[0] = __builtin_bit_cast(float, b.x << 16) + acc[ai][bj][m][0][0]; o0[1] = __builtin_bit_cast(float, b.x & 0xffff0000u) + acc[ai][bj][m][0][1];
                    o0[2] = __builtin_bit_cast(float, b.y << 16) + acc[ai][bj][m][0][2]; o0[3] = __builtin_bit_cast(float, b.y & 0xffff0000u) + acc[ai][bj][m][0][3];
                    o1[0] = __builtin_bit_cast(float, b.z << 16) + acc[ai][bj][m][1][0]; o1[1] = __builtin_bit_cast(float, b.z & 0xffff0000u) + acc[ai][bj][m][1][1];
                    o1[2] = __builtin_bit_cast(float, b.w << 16) + acc[ai][bj][m][1][2]; o1[3] = __builtin_bit_cast(float, b.w & 0xffff0000u) + acc[ai][bj][m][1][3];
                    s += ((o0[0] * o0[0] + o0[1] * o0[1]) + (o0[2] * o0[2] + o0[3] * o0[3])) + ((o1[0] * o1[0] + o1[1] * o1[1]) + (o1[2] * o1[2] + o1[3] * o1[3]));
                    u32x4 w; w.x = cvt_pk_bf16(o0[0], o0[1]); w.y = cvt_pk_bf16(o0[2], o0[3]); w.z = cvt_pk_bf16(o1[0], o1[1]); w.w = cvt_pk_bf16(o1[2], o1[3]);
                    *(u32x4*)(hb + off + bj * HALF) = w; }
                s += __shfl_xor(s, 16); s += __shfl_xor(s, 32);
                if (fq == 0) atomicAdd(ssq + r, s); }
    }
};
struct OneUnit {
    Unit u;
    __device__ __forceinline__ bool next(int i, Unit& o) const { if (i) return false; o = u; return true; }
    __device__ __forceinline__ void a_ready(const Unit&) const {}
    __device__ __forceinline__ void done(const Unit&) const {}
};
struct EpiDft1 {
    static constexpr bool PERM = true, AFTER_DRAIN = true;
    bf16_t* Tp; PG8_LAS unsigned char* lds;
    __device__ __forceinline__ void operator()(const f32x4 (&acc)[2][2][4][2], const Unit& u, int wr, int wc, int, int) const {
        int l_ = (int)lane_id_fresh(); asm volatile("" : "+v"(l_));
        const int fr = l_ & 15, fq = l_ >> 4;
        const int s1p = fr, kg = fq, part = kg >> 1, s1b = 8 * (kg & 1);
        bf16x8 bre, bim;
#pragma unroll
        for (int j = 0; j < 8; ++j) { const float ang = (float)(((s1b + j) * s1p) & 15) * (1.0f / 16.0f); const float c = __builtin_amdgcn_cosf(ang), sn = __builtin_amdgcn_sinf(ang);
            const float vre = part == 0 ? c : -sn, vim = part == 0 ? -sn : -c;
            bre[j] = (short)(cvt_pk_bf16(vre, 0.f) & 0xffffu); bim[j] = (short)(cvt_pk_bf16(vim, 0.f) & 0xffffu); }
        const int q = u.pn & 15, b = u.pn >> 4;
        float tc[4], ts[4];
#pragma unroll
        for (int i = 0; i < 4; ++i) { const float ang = (float)((q * 16 + 4 * kg + i) * s1p) * (1.0f / 4096.0f); tc[i] = __builtin_amdgcn_cosf(ang); ts[i] = __builtin_amdgcn_sinf(ang); }
        asm volatile("s_waitcnt vmcnt(0)" ::: "memory"); __builtin_amdgcn_s_barrier();
#pragma unroll
        for (int ai = 0; ai < 2; ++ai)
#pragma unroll
            for (int m = 0; m < 4; ++m) { const int R = ai * HALF + wr * 64 + m * 16 + fr;
#pragma unroll
                for (int bj = 0; bj < 2; ++bj) { const int c = 16 * bj + 4 * wc + fq, slot = ((c >> 1) + 16 * (c & 1)) ^ fr;
                    const f32x4 v0 = acc[ai][bj][m][0], v1 = acc[ai][bj][m][1];
                    u32x4 w; w.x = cvt_pk_bf16(v0[0], v0[1]); w.y = cvt_pk_bf16(v0[2], v0[3]); w.z = cvt_pk_bf16(v1[0], v1[1]); w.w = cvt_pk_bf16(v1[2], v1[3]);
                    *(PG8_LAS u32x4*)(lds + R * 512 + slot * 16) = w; } }
        asm volatile("s_waitcnt lgkmcnt(0)" ::: "memory"); __builtin_amdgcn_s_barrier();
        const int nl0 = (wr * 4 + wc) * 16;
        bf16_t* tout = Tp + (((size_t)b * 1024 + u.pm * 128 + nl0) * 16 + s1p) * 512 + q * 32 + 8 * kg;
        const int rdslot = s1p + 16 * (kg & 1);
#pragma unroll 4
        for (int j = 0; j < 16; ++j) { const int R = 2 * (nl0 + j) + part;
            const bf16x8 av = *(const PG8_LAS bf16x8*)(lds + R * 512 + ((rdslot ^ (R & 15)) * 16));
            const f32x4 z4 = {0.f, 0.f, 0.f, 0.f};
            const f32x4 cre = __builtin_amdgcn_mfma_f32_16x16x32_bf16(av, bre, z4, 0, 0, 0), cim = __builtin_amdgcn_mfma_f32_16x16x32_bf16(av, bim, z4, 0, 0, 0);
            u32x4 w;
            w.x = cvt_pk_bf16(cre[0] * tc[0] + cim[0] * ts[0], cim[0] * tc[0] - cre[0] * ts[0]); w.y = cvt_pk_bf16(cre[1] * tc[1] + cim[1] * ts[1], cim[1] * tc[1] - cre[1] * ts[1]);
            w.z = cvt_pk_bf16(cre[2] * tc[2] + cim[2] * ts[2], cim[2] * tc[2] - cre[2] * ts[2]); w.w = cvt_pk_bf16(cre[3] * tc[3] + cim[3] * ts[3], cim[3] * tc[3] - cre[3] * ts[3]);
            *(u32x4*)(tout + (size_t)j * 16 * 512) = w; }
    }
};
struct EpiResOut {
    static constexpr bool PERM = true, AFTER_DRAIN = false;
    const bf16_t* hb; float* ssq; float* out; const float* gf; unsigned* cnt; unsigned* tmo; int ldc; unsigned need;
    __device__ __forceinline__ void operator()(f32x4 (&acc)[2][2][4][2], const Unit& u, int wr, int wc, int fr, int fq) const {
        int l_ = (int)lane_id_fresh(); asm volatile("" : "+v"(l_)); fr = l_ & 15; fq = l_ >> 4;
        const int row0 = u.pm * BM + wr * 64 + fr, col0 = u.pn * BM + wc * 32 + 8 * fq;
        {
            u32x4 bv[2][4][2];
#pragma unroll
            for (int ai = 0; ai < 2; ++ai)
#pragma unroll
                for (int m = 0; m < 4; ++m) { const size_t off = (size_t)(row0 + ai * HALF + m * 16) * ldc + col0;
#pragma unroll
                    for (int bj = 0; bj < 2; ++bj) bv[ai][m][bj] = __builtin_nontemporal_load((const u32x4*)(hb + off + bj * HALF)); }
#pragma unroll
            for (int ai = 0; ai < 2; ++ai)
#pragma unroll
                for (int m = 0; m < 4; ++m) { const int r = row0 + ai * HALF + m * 16; float s = 0.f;
#pragma unroll
                    for (int bj = 0; bj < 2; ++bj) { const u32x4 b = bv[ai][m][bj];
                        f32x4 o0 = acc[ai][bj][m][0], o1 = acc[ai][bj][m][1];
                        o0[0] += __builtin_bit_cast(float, b.x << 16); o0[1] += __builtin_bit_cast(float, b.x & 0xffff0000u);
                        o0[2] += __builtin_bit_cast(float, b.y << 16); o0[3] += __builtin_bit_cast(float, b.y & 0xffff0000u);
                        o1[0] += __builtin_bit_cast(float, b.z << 16); o1[1] += __builtin_bit_cast(float, b.z & 0xffff0000u);
                        o1[2] += __builtin_bit_cast(float, b.w << 16); o1[3] += __builtin_bit_cast(float, b.w & 0xffff0000u);
                        s += ((o0[0] * o0[0] + o0[1] * o0[1]) + (o0[2] * o0[2] + o0[3] * o0[3])) + ((o1[0] * o1[0] + o1[1] * o1[1]) + (o1[2] * o1[2] + o1[3] * o1[3]));
                        acc[ai][bj][m][0] = o0; acc[ai][bj][m][1] = o1; }
                    s += __shfl_xor(s, 16); s += __shfl_xor(s, 32);
                    if (fq == 0) atomicAdd(ssq + r, s); }
        }
        asm volatile("s_waitcnt vmcnt(0)" ::: "memory");
        unsigned* c = cnt + (u.pm * 2 + wr) * 16;
        if (l_ == 0) (void)__hip_atomic_fetch_add(c, 1u, __ATOMIC_RELAXED, __HIP_MEMORY_SCOPE_AGENT);
        f32x4 gv[2][2];
#pragma unroll
        for (int bj = 0; bj < 2; ++bj)
#pragma unroll
            for (int n = 0; n < 2; ++n) gv[bj][n] = *(const f32x4*)(gf + col0 + bj * HALF + 4 * n);
        { unsigned sp = 0u;
          while (__hip_atomic_load(c, __ATOMIC_RELAXED, __HIP_MEMORY_SCOPE_AGENT) < need) { __builtin_amdgcn_s_sleep(1);
              if ((++sp & 255u) == 0u) { if (__hip_atomic_load(tmo, __ATOMIC_RELAXED, __HIP_MEMORY_SCOPE_AGENT)) break; if (sp > (1u << 20)) { atomicAdd(tmo, 1u); break; } } } }
        float iv[2][4];
#pragma unroll
        for (int ai = 0; ai < 2; ++ai)
#pragma unroll
            for (int m = 0; m < 4; ++m) iv[ai][m] = __hip_atomic_load(ssq + row0 + ai * HALF + m * 16, __ATOMIC_RELAXED, __HIP_MEMORY_SCOPE_AGENT);
#pragma unroll
        for (int ai = 0; ai < 2; ++ai)
#pragma unroll
            for (int m = 0; m < 4; ++m) { const float inv = __builtin_amdgcn_rsqf(iv[ai][m] * (1.0f / DM) + EPS); float* rowp = out + (size_t)(row0 + ai * HALF + m * 16) * ldc + col0;
#pragma unroll
                for (int bj = 0; bj < 2; ++bj) { *(f32x4*)(rowp + bj * HALF) = acc[ai][bj][m][0] * inv * gv[bj][0]; *(f32x4*)(rowp + bj * HALF + 4) = acc[ai][bj][m][1] * inv * gv[bj][1]; } }
    }
};
struct EpiY {
    static constexpr bool PERM = true, AFTER_DRAIN = false;
    bf16_t* O; int ldc;
    __device__ __forceinline__ void operator()(const f32x4 (&acc)[2][2][4][2], const Unit& u, int wr, int wc, int fr, int fq) const {
        { int l_ = (int)lane_id_fresh(); asm volatile("" : "+v"(l_)); fr = l_ & 15; fq = l_ >> 4; }
        const int rl0 = wr * 64 + fr, col0 = u.pn * BM + wc * 32 + 8 * fq; const int tok0 = (u.pm >> 4) * 4096 + (u.pm & 15);
#pragma unroll
        for (int ai = 0; ai < 2; ++ai)
#pragma unroll
            for (int m = 0; m < 4; ++m) { const int rl = rl0 + ai * HALF + m * 16; bf16_t* rowp = O + (size_t)(tok0 + 16 * rl) * ldc + col0;
#pragma unroll
                for (int bj = 0; bj < 2; ++bj) { const f32x4 v0 = acc[ai][bj][m][0], v1 = acc[ai][bj][m][1];
                    u32x4 w; w.x = cvt_pk_bf16(v0[0], v0[1]); w.y = cvt_pk_bf16(v0[2], v0[3]); w.z = cvt_pk_bf16(v1[0], v1[1]); w.w = cvt_pk_bf16(v1[2], v1[3]);
                    *(u32x4*)(rowp + bj * HALF) = w; } }
    }
};

typedef int v4i_t __attribute__((ext_vector_type(4)));
template <class Epi, class Sched, class Addr, bool ALIGN_EPI, int TSW = 0>
__device__ __forceinline__ void gemm_phase(PG8_LAS unsigned char* lds, const int K, const Addr g, const Sched& S, const Epi& E, const int wid  ) {
    int lane_ = (int)lane_id_fresh(); asm volatile("" : "+v"(lane_));
    const int lane = lane_, tid = wid * 64 + lane, wr = wid >> 2, wc = wid & 3, fr = lane & 15, fq = lane >> 4;
    const int nt = K / BK;
    unsigned voffA[2], voffB[2];
#pragma unroll
    for (int i = 0; i < 2; ++i) { int R, C; stage_rc(tid * 16 + i * 8192, R, C); const int Rb = Epi::PERM ? ((R & ~31) + perm32(R & 31)) : R;
        voffA[i] = g.voffA(R, C); voffB[i] = g.voffB(Rb, C); }
    const size_t kstep = (size_t)(BK * 2);
    const size_t hstepA = g.hA(), hstepB = g.hB();
    const unsigned ldsw = (unsigned)wid * 1024u;
    const int aoff = lds_byte(wr * 64 + fr, fq * 8), boff = lds_byte(wc * 32 + fr, fq * 8);
#define PG8_SA(b, h) (((b) * 2 + (h)) * HTB)
#define PG8_SB(b, h) ((4 + (b) * 2 + (h)) * HTB)
#define PG8_STAGE(bufoff, gbase, voff) do { _Pragma("unroll") for (int _i = 0; _i < 2; ++_i) { unsigned _vo = (voff)[_i]; asm volatile("" : "+v"(_vo)); \
        __builtin_amdgcn_global_load_lds((const PG8_GAS unsigned*)((const PG8_GAS char*)(gbase) + _vo), (PG8_LAS unsigned*)(lds + (bufoff) + ldsw + _i * 8192), 16, 0, 0); } } while (0)
#define PG8_LDA(dst, b, h) do { _Pragma("unroll") for (int m = 0; m < 4; ++m) _Pragma("unroll") for (int k = 0; k < 2; ++k) dst[m][k] = *(const PG8_LAS bf16x8*)(lds + PG8_SA(b, h) + aoff + m * 2048 + k * 1024); } while (0)
#define PG8_LDB(dst, b, h) do { _Pragma("unroll") for (int n = 0; n < 2; ++n) _Pragma("unroll") for (int k = 0; k < 2; ++k) dst[n][k] = *(const PG8_LAS bf16x8*)(lds + PG8_SB(b, h) + boff + n * 2048 + k * 1024); } while (0)
#define PG8_MMA(ai, bj, At, Bt) do { __builtin_amdgcn_s_setprio(1); _Pragma("unroll") for (int m = 0; m < 4; ++m) _Pragma("unroll") for (int n = 0; n < 2; ++n) _Pragma("unroll") for (int k = 0; k < 2; ++k) \
        acc[ai][bj][m][n] = __builtin_amdgcn_mfma_f32_16x16x32_bf16(Bt[n][k], At[m][k], acc[ai][bj][m][n], 0, 0, 0); __builtin_amdgcn_s_setprio(0); } while (0)
#define PG8_CAT(x, y) __builtin_shufflevector(__builtin_bit_cast(v4i_t, x), __builtin_bit_cast(v4i_t, y), 0, 1, 2, 3, 4, 5, 6, 7)
#define PG8_MMA8(ai, bj, At, Bt) do { __builtin_amdgcn_s_setprio(1); _Pragma("unroll") for (int m = 0; m < 4; ++m) _Pragma("unroll") for (int n = 0; n < 2; ++n) \
        acc[ai][bj][m][n] = __builtin_amdgcn_mfma_scale_f32_16x16x128_f8f6f4(PG8_CAT(Bt[n][0], Bt[n][1]), PG8_CAT(At[m][0], At[m][1]), acc[ai][bj][m][n], 0, 0, 0, 0, 0, 0); __builtin_amdgcn_s_setprio(0); } while (0)
#define PG8_WAIT_V(n) asm volatile("s_waitcnt vmcnt(" #n ")" ::: "memory")
#define PG8_WAIT_L(n) asm volatile("s_waitcnt lgkmcnt(" #n ")" ::: "memory")
#define PG8_BAR __builtin_amdgcn_s_barrier()
#define PG8_SCHED __builtin_amdgcn_sched_barrier(0)
    Unit cur, nxt; int ui = 0;
    if (!S.next(0, cur)) return;
    f32x4 acc[2][2][4][2];
#pragma unroll
    for (int a = 0; a < 2; ++a)
#pragma unroll
        for (int b = 0; b < 2; ++b)
#pragma unroll
            for (int m = 0; m < 4; ++m)
#pragma unroll
                for (int n = 0; n < 2; ++n) acc[a][b][m][n] = (f32x4){0.f, 0.f, 0.f, 0.f};
    bf16x8 At[4][2], B0[2][2], B1[2][2];
    const char* cA = g.a(cur); const char* cB = g.b(cur);
    S.a_ready(cur);
    PG8_STAGE(PG8_SB(0, 0), cB, voffB); PG8_STAGE(PG8_SB(0, 1), cB + hstepB, voffB); PG8_STAGE(PG8_SA(0, 0), cA, voffA); PG8_STAGE(PG8_SA(0, 1), cA + hstepA, voffA);
    if (wr == 1) PG8_BAR;
    PG8_WAIT_V(2); PG8_BAR;
    PG8_STAGE(PG8_SB(1, 0), cB + kstep, voffB); PG8_STAGE(PG8_SA(1, 0), cA + kstep, voffA); PG8_STAGE(PG8_SB(1, 1), cB + hstepB + kstep, voffB);
    PG8_WAIT_V(6); PG8_BAR;
    for (;;) {
        const bool has_next = S.next(ui + 1, nxt);
        const char* nA = has_next ? g.a(nxt) : cA;
        const char* nB = has_next ? g.b(nxt) : cB;
#define PG8_BODY(MM) \
            const bool last = (t == nt - 2); \
            const char* a1 = cA + (size_t)(t + 1) * kstep; \
            const char* a2 = last ? nA : cA + (size_t)(t + 2) * kstep; const char* b2 = last ? nB : cB + (size_t)(t + 2) * kstep; \
            const char* a3 = a2 + kstep; const char* b3 = b2 + kstep; \
            if (last && has_next) S.a_ready(nxt); \
            PG8_LDB(B0, 0, 0); PG8_LDB(B1, 0, 1); PG8_SCHED; PG8_LDA(At, 0, 0); PG8_STAGE(PG8_SA(1, 1), a1 + hstepA, voffA); \
            PG8_WAIT_V(8); PG8_WAIT_L(0); PG8_BAR; MM(0, 0, At, B0); MM(0, 1, At, B1); PG8_BAR; PG8_SCHED; \
            PG8_LDA(At, 0, 1); PG8_STAGE(PG8_SB(0, 0), b2, voffB); PG8_STAGE(PG8_SB(0, 1), b2 + hstepB, voffB); PG8_STAGE(PG8_SA(0, 0), a2, voffA); \
            PG8_WAIT_V(8); PG8_WAIT_L(0); PG8_BAR; MM(1, 0, At, B0); MM(1, 1, At, B1); PG8_BAR; PG8_SCHED; \
            PG8_LDB(B0, 1, 0); PG8_LDB(B1, 1, 1); PG8_SCHED; PG8_LDA(At, 1, 0); PG8_STAGE(PG8_SA(0, 1), a2 + hstepA, voffA); \
            PG8_WAIT_V(8); PG8_WAIT_L(0); PG8_BAR; MM(0, 0, At, B0); MM(0, 1, At, B1); PG8_BAR; PG8_SCHED; \
            PG8_LDA(At, 1, 1); PG8_STAGE(PG8_SB(1, 0), b3, voffB); PG8_STAGE(PG8_SB(1, 1), b3 + hstepB, voffB); PG8_STAGE(PG8_SA(1, 0), a3, voffA); \
            PG8_WAIT_V(8); PG8_WAIT_L(0); PG8_BAR; MM(1, 0, At, B0); MM(1, 1, At, B1); PG8_BAR; PG8_SCHED;
        { const int tmid = (TSW > 0 && TSW < nt) ? TSW : nt;
          _Pragma("unroll 1") for (int t = 0; t < tmid; t += 2) { PG8_BODY(PG8_MMA) }
          if constexpr (TSW > 0) { _Pragma("unroll 1") for (int t = tmid; t < nt; t += 2) { PG8_BODY(PG8_MMA8) } } }
#undef PG8_BODY
        if constexpr (ALIGN_EPI) { if (wr == 0) PG8_BAR; }
        E(acc, cur, wr, wc, 0, 0); S.done(cur);
        if (!has_next) break;
#pragma unroll
        for (int a = 0; a < 2; ++a)
#pragma unroll
            for (int b = 0; b < 2; ++b)
#pragma unroll
                for (int m = 0; m < 4; ++m)
#pragma unroll
                    for (int n = 0; n < 2; ++n) acc[a][b][m][n] = (f32x4){0.f, 0.f, 0.f, 0.f};
        cur = nxt; cA = nA; cB = nB; ++ui;
        if constexpr (ALIGN_EPI) { if (wr == 1) PG8_BAR; }
    }
    if constexpr (!Epi::AFTER_DRAIN) PG8_WAIT_V(0);
    if constexpr (!ALIGN_EPI) { if (wr == 0) PG8_BAR; }
    PG8_BAR;
#undef PG8_SA
#undef PG8_SB
#undef PG8_STAGE
#undef PG8_LDA
#undef PG8_LDB
#undef PG8_MMA
#undef PG8_MMA8
#undef PG8_CAT
#undef PG8_WAIT_V
#undef PG8_WAIT_L
#undef PG8_BAR
#undef PG8_SCHED
}
}

typedef unsigned short bf16_t;
typedef short bf16x8 __attribute__((ext_vector_type(8)));
typedef float f32x4 __attribute__((ext_vector_type(4)));
typedef unsigned v4u __attribute__((ext_vector_type(4)));
#define GAS __attribute__((address_space(1)))
#define LAS __attribute__((address_space(3)))
using pg8::lane_id_fresh;
constexpr int NWAVES = 8;
constexpr int WGM_F = 16, WGM_Q = 8, WGM_O = 1, WGM_U = 4, WGM_D = 4;

constexpr size_t MiB = 1u << 20;
constexpr size_t WS_CTL = 0, CTL_ZERO_BYTES = 1 * MiB;
constexpr int CW_BAR = 4096;
constexpr int CW_EXCH = 16384;
constexpr size_t WS_SSQ1 = 256 * 1024;
constexpr size_t WS_SSQ2 = 384 * 1024;
constexpr size_t WS_INV0 = 1 * MiB;
constexpr size_t WS_TRIG2 = 3 * MiB;
constexpr size_t WS_ABT  = 2 * MiB;
constexpr size_t WS_WINT = 4 * MiB;
constexpr size_t WS_WO   = 28 * MiB;
constexpr size_t WS_WUP  = 36 * MiB;
constexpr size_t WS_WD   = 68 * MiB;
constexpr size_t WS_H1B  = 100 * MiB;
constexpr size_t WS_XB   = 164 * MiB;
constexpr size_t WS_Y    = 324 * MiB;
constexpr size_t WS_Q    = 228 * MiB;
constexpr size_t WS_ZT   = 388 * MiB;
constexpr size_t WS_A    = 324 * MiB;
constexpr size_t WS_END  = 452 * MiB;
static_assert(WS_SSQ2 + (size_t)T * 4 <= CTL_ZERO_BYTES, "ssq inside the memset region");

constexpr int RING_BYTES = 131072;
constexpr int LDSCTL_OFF = RING_BYTES, MISC_OFF = LDSCTL_OFF + 320;
constexpr int LDS_BYTES = 147456;

#define LDS_WAIT() asm volatile("s_waitcnt lgkmcnt(0)" ::: "memory")
__device__ __forceinline__ unsigned f2bf(float f) { unsigned u = __builtin_bit_cast(unsigned, f); return (u + 0x7fffu + ((u >> 16) & 1u)) >> 16; }
__device__ __forceinline__ unsigned pk2(float lo, float hi) { return f2bf(lo) | (f2bf(hi) << 16); }
__device__ __forceinline__ float bf2f(unsigned v) { return __builtin_bit_cast(float, v << 16); }
__device__ __forceinline__ float wave_sum(float v) {
#pragma unroll
    for (int o = 1; o < 64; o <<= 1) v += __shfl_xor(v, o);
    return v;
}
__device__ __forceinline__ float wave_max(float v) {
#pragma unroll
    for (int o = 1; o < 64; o <<= 1) v = fmaxf(v, __shfl_xor(v, o));
    return v;
}

#define XB_TMO      128
#define XB_XCNT(j)  (256  + 64 * (j))
#define XB_XSUB(j)  (1280 + 64 * (j))
#define XB_XGEN(j)  (2304 + 64 * (j))
#define XB_TOP      3328
#define XB_TOPGEN   3392
#define XCD_BAR_WORDS 3456
#define XB_SPIN_CAP (1u << 20)
__device__ __forceinline__ unsigned xb_ld(unsigned* p)              { return __hip_atomic_load(p, __ATOMIC_RELAXED, __HIP_MEMORY_SCOPE_AGENT); }
__device__ __forceinline__ unsigned xb_add(unsigned* p, unsigned v) { return __hip_atomic_fetch_add(p, v, __ATOMIC_RELAXED, __HIP_MEMORY_SCOPE_AGENT); }
__device__ __forceinline__ unsigned xb_xcc_id() { return (unsigned)__builtin_amdgcn_s_getreg((3 << 11) | 20) & 0xFu; }
#define XB_SPIN(cond, bar) do { unsigned _sp = 0; while (cond) { __builtin_amdgcn_s_sleep(1); \
    if ((++_sp & 255u) == 0u) { if (xb_ld(&(bar)[XB_TMO])) break; if (_sp > XB_SPIN_CAP) { atomicAdd(&(bar)[XB_TMO], 1u); break; } } } } while (0)
struct XcdBarrier { unsigned* bar; unsigned x; volatile LAS unsigned* st; };
__device__ __forceinline__ XcdBarrier xcd_barrier_post(unsigned* bar, volatile LAS unsigned* st) {
    XcdBarrier b; b.bar = bar; b.x = xb_xcc_id(); b.st = st;
    if (threadIdx.x == 0) (void)xb_add(&bar[XB_XCNT(b.x)], 1u);
    return b;
}
__device__ __forceinline__ void xcd_barrier_complete(unsigned* bar, unsigned x, unsigned& nloc, unsigned& nx) {
    const unsigned G = gridDim.x * gridDim.y * gridDim.z;
    unsigned sum, cnt, mine, sp = 0u;
    for (;;) {
        sum = 0u; cnt = 0u; mine = 0u;
#pragma unroll
        for (unsigned j = 0; j < 16; ++j) { const unsigned c = xb_ld(&bar[XB_XCNT(j)]); sum += c; cnt += (c > 0u) ? 1u : 0u; mine = (j == x) ? c : mine; }
        if (sum == G) break;
        __builtin_amdgcn_s_sleep(1);
        if ((++sp & 255u) == 0u) { if (xb_ld(&bar[XB_TMO])) break; if (sp > XB_SPIN_CAP) { atomicAdd(&bar[XB_TMO], 1u); break; } }
    }
    nloc = mine > 0u ? mine : 1u; nx = cnt > 0u ? cnt : 1u;
}
__device__ __forceinline__ void xcd_barrier(const XcdBarrier& b, const int wave) {
    asm volatile("s_waitcnt vmcnt(0)" ::: "memory");
    __syncthreads();
    if (wave == 0 && lane_id_fresh() == 0u) {
        unsigned* bar = b.bar;
        __builtin_amdgcn_s_waitcnt(0);
        unsigned nloc = b.st[0], nx = b.st[1];
        if (nloc == 0u) { xcd_barrier_complete(bar, b.x, nloc, nx); b.st[0] = nloc; b.st[1] = nx; }
        const unsigned old = xb_add(&bar[XB_XSUB(b.x)], 1u);
        const unsigned gen = old / nloc;
        if (old + 1u == (gen + 1u) * nloc) {
            __builtin_amdgcn_fence(__ATOMIC_RELEASE, "agent");
            asm volatile("s_waitcnt vmcnt(0)" ::: "memory");
            const unsigned og = xb_add(&bar[XB_TOP], 1u);
            const unsigned tg = og / nx;
            if (og + 1u == (tg + 1u) * nx) xb_add(&bar[XB_TOPGEN], 1u);
            else XB_SPIN(xb_ld(&bar[XB_TOPGEN]) == tg, bar);
            __builtin_amdgcn_fence(__ATOMIC_ACQUIRE, "agent");
            xb_add(&bar[XB_XGEN(b.x)], 1u);
            asm volatile("s_waitcnt vmcnt(0)" ::: "memory");
        } else {
            XB_SPIN(xb_ld(&bar[XB_XGEN(b.x)]) == gen, bar);
            __builtin_amdgcn_fence(__ATOMIC_ACQUIRE, "agent");
            asm volatile("s_waitcnt vmcnt(0)" ::: "memory");
        }
    }
    __syncthreads();
}

__device__ __forceinline__ void p0_transpose_item(const float* W, int ldw, int col_off, int K, int N, const float* rs, bf16_t* WT, LAS float* scr, int item, int lane) {
    const int nblk = N / 32, kb = item / nblk, nb = item % nblk, k0 = 64 * kb, n0 = 32 * nb;
    const int r8 = lane >> 3, c4 = (lane & 7) * 4;
    f32x4 v[8]; float sc[8];
#pragma unroll
    for (int i = 0; i < 8; ++i) { const int kk = 8 * i + r8; v[i] = __builtin_nontemporal_load((const GAS f32x4*)(W + (size_t)(k0 + kk) * ldw + col_off + n0 + c4)); sc[i] = rs ? rs[k0 + kk] : 1.0f; }
#pragma unroll
    for (int i = 0; i < 8; ++i) { LAS float* d = scr + (8 * i + r8) * 33 + c4; d[0] = v[i].x * sc[i]; d[1] = v[i].y * sc[i]; d[2] = v[i].z * sc[i]; d[3] = v[i].w * sc[i]; }
    LDS_WAIT();
    const int c = lane & 7;
#pragma unroll
    for (int j = 0; j < 4; ++j) { const int n = (lane >> 3) + 8 * j; const LAS float* s = scr + (8 * c) * 33 + n;
        v4u o; o.x = pk2(s[0 * 33], s[1 * 33]); o.y = pk2(s[2 * 33], s[3 * 33]); o.z = pk2(s[4 * 33], s[5 * 33]); o.w = pk2(s[6 * 33], s[7 * 33]);
        *(GAS v4u*)(WT + (size_t)(n0 + n) * K + k0 + 8 * c) = o; }
    LDS_WAIT();
}

__device__ __forceinline__ void p0_transpose_item_wo(const float* W, bf16_t* WT, LAS float* scr, int item, int lane) {
    const int kb = item >> 6, nb = item & 63, k0 = 64 * kb, n0 = 32 * nb;
    const int r8 = lane >> 3, c4 = (lane & 7) * 4;
    f32x4 v[8];
#pragma unroll
    for (int i = 0; i < 8; ++i) { const int kk = 8 * i + r8; v[i] = __builtin_nontemporal_load((const GAS f32x4*)(W + (size_t)(k0 + kk) * 2048 + n0 + c4)); }
#pragma unroll
    for (int i = 0; i < 8; ++i) { LAS float* d = scr + (8 * i + r8) * 33 + c4; d[0] = v[i].x * 32.f; d[1] = v[i].y * 32.f; d[2] = v[i].z * 32.f; d[3] = v[i].w * 32.f; }
    LDS_WAIT();
    const int c = lane & 7;
#pragma unroll
    for (int j = 0; j < 4; ++j) { const int n = (lane >> 3) + 8 * j; const LAS float* s = scr + (8 * c) * 33 + n;
        GAS unsigned char* row = (GAS unsigned char*)WT + (size_t)(n0 + n) * 3072;
        if (k0 < 1024) { v4u o; o.x = pk2(s[0 * 33], s[1 * 33]); o.y = pk2(s[2 * 33], s[3 * 33]); o.z = pk2(s[4 * 33], s[5 * 33]); o.w = pk2(s[6 * 33], s[7 * 33]);
            *(GAS v4u*)(row + (k0 + 8 * c) * 2) = o; }
        else { pg8::u32x2 o; o.x = pg8::pk_fp8x4((f32x4){s[0 * 33], s[1 * 33], s[2 * 33], s[3 * 33]}); o.y = pg8::pk_fp8x4((f32x4){s[4 * 33], s[5 * 33], s[6 * 33], s[7 * 33]});
            *(GAS pg8::u32x2*)(row + 2048 + (k0 - 1024) + 8 * c) = o; } }
    LDS_WAIT();
}

typedef float f32x16 __attribute__((ext_vector_type(16)));
typedef short s16x4 __attribute__((ext_vector_type(4)));
typedef unsigned u32x2 __attribute__((ext_vector_type(2)));
typedef float f32x2 __attribute__((ext_vector_type(2)));
__device__ __forceinline__ unsigned cvtpk(float lo, float hi) { unsigned r; asm volatile("v_cvt_pk_bf16_f32 %0, %1, %2" : "=v"(r) : "v"(lo), "v"(hi)); return r; }
#define SBAR() __builtin_amdgcn_sched_barrier(0)
constexpr float AT_THR = 8.0f;
constexpr int at_v_rd_off(int d0, int ks, int half) { return d0 * 512 + ks * 4096 + half * 2048; }
template <int OFF> __device__ __forceinline__ s16x4 tr_read(unsigned vb) {
    s16x4 r; asm volatile("ds_read_b64_tr_b16 %0, %1 offset:%2" : "=&v"(r) : "v"(vb), "i"(OFF) : "memory"); return r;
}
__device__ __forceinline__ int clampi(int v, int lo, int hi) { return v < lo ? lo : (v > hi ? hi : v); }
__device__ __forceinline__ void at_dma_k(LAS unsigned char* kdst, const bf16_t* kbase, int tq0, int dil, int tile, int lane_) {
    int lane = lane_; asm volatile("" : "+v"(lane));
    const int r0 = lane >> 3; const unsigned c0 = (unsigned)(((lane & 7) ^ r0) << 4);
    const int t0 = tq0 + dil * (32 * tile + r0 - 64), d8 = 8 * dil;
#pragma unroll
    for (int n = 0; n < 4; ++n) { int tkn = t0 + n * d8; tkn = tkn < 0 ? 0 : (tkn > SEQ - 1 ? SEQ - 1 : tkn);
        const unsigned off = ((unsigned)tkn << 7) + c0;
        __builtin_amdgcn_global_load_lds((const unsigned*)((const GAS char*)kbase + off), (LAS unsigned*)(kdst + n * 1024), 16, 0, 0); }
}
__device__ __forceinline__ long bf16x8_to_fp8(const bf16x8 v) {
    const v4u w = __builtin_bit_cast(v4u, v);
    int lo = __builtin_amdgcn_cvt_pk_fp8_f32(__builtin_bit_cast(float, w.x << 16), __builtin_bit_cast(float, w.x & 0xffff0000u), 0, false);
    lo = __builtin_amdgcn_cvt_pk_fp8_f32(__builtin_bit_cast(float, w.y << 16), __builtin_bit_cast(float, w.y & 0xffff0000u), lo, true);
    int hi = __builtin_amdgcn_cvt_pk_fp8_f32(__builtin_bit_cast(float, w.z << 16), __builtin_bit_cast(float, w.z & 0xffff0000u), 0, false);
    hi = __builtin_amdgcn_cvt_pk_fp8_f32(__builtin_bit_cast(float, w.w << 16), __builtin_bit_cast(float, w.w & 0xffff0000u), hi, true);
    return (long)(((unsigned long long)(unsigned)hi << 32) | (unsigned long long)(unsigned)lo);
}
__device__ __forceinline__ void at_dma_v(LAS unsigned char* vdst, const bf16_t* vbase, int tq0, int dil, int tile, int lane_) { at_dma_k(vdst, vbase, tq0, dil, tile, lane_); }
template <int OFF> __device__ __forceinline__ long tr8_read(unsigned vb) {
    long r; asm volatile("ds_read_b64_tr_b8 %0, %1 offset:%2" : "=&v"(r) : "v"(vb), "i"(OFF) : "memory"); return r;
}
constexpr int TRB8_MAP = 0;
__device__ __forceinline__ void at_load_q(bf16x8 (&qr)[8], const bf16_t* qb, int tq0, int dil, int lane) {
    const bf16_t* qrow = qb + (size_t)(tq0 + dil * (lane & 31)) * 128 + (lane >> 5) * 8;
#pragma unroll
    for (int s = 0; s < 8; ++s) qr[s] = *(const GAS bf16x8*)(qrow + 16 * s);
}
__device__ __forceinline__ void at_unit_prologue(LAS unsigned char* wl, bf16x8 (&qr)[8], const bf16_t* qb, const bf16_t* kb, const bf16_t* vb, int tq0, int dil, int lane) {
    at_dma_k(wl, kb, tq0, dil, 0, lane); at_dma_v(wl + 8192, vb, tq0, dil, 0, lane); at_load_q(qr, qb, tq0, dil, lane);
}
__device__ __forceinline__ void attn_unit(const bool FINAL, const bool HN, LAS unsigned char* wl, const bf16_t* qb, const bf16_t* kb, const bf16_t* vb, int tq0, int dil, float sl, bf16x8 (&qr)[8], const bf16_t* nqb, const bf16_t* nkb, const bf16_t* nvb, int ntq0, int ndil,
                                          bf16_t* part, float* ml, const bf16_t* part0, const bf16_t* part1, const float* ml0, const float* ml1, bf16_t* yout, int lane) {
    const int r32 = lane & 31, hi = lane >> 5;
    LAS unsigned char* kbuf = wl; LAS unsigned char* vbuf = wl + 8192;
    const int jlo = 64 - tq0 / dil, jhi = 64 + (SEQ - 1 - tq0) / dil;
    const float lo_i = (float)max(-64, jlo - 64 - r32), hi_i = (float)min(64, jhi - 64 - r32);
    const bool interior = (jlo <= 0) && (jhi >= 159);
    float m_run = -1e30f, l_run = 0.f;
    f32x16 oT[4];
#pragma unroll
    for (int d0 = 0; d0 < 4; ++d0)
#pragma unroll
        for (int r = 0; r < 16; ++r) oT[d0][r] = 0.f;
    asm volatile("s_waitcnt vmcnt(0)" ::: "memory");
#pragma unroll
    for (int s = 0; s < 8; ++s) asm volatile("" : "+v"(qr[s]));
    long q8[8];
#pragma unroll
    for (int s = 0; s < 8; ++s) q8[s] = bf16x8_to_fp8(qr[s]);
    f32x2 st1 = {0.f, 0.f}, st2 = {0.f, 0.f};
    if (FINAL) { const size_t tqs = (size_t)(tq0 + dil * r32) * 2; st1 = *(const GAS f32x2*)(ml0 + tqs); st2 = *(const GAS f32x2*)(ml1 + tqs); }
    const int rr0 = lane >> 4, cs = lane & 15;
    const LAS unsigned char* krd = kbuf + r32 * 128 + hi * 8;
    const int kx = (r32 & 7) << 4;
#pragma unroll 1
    for (int n = 0; n < 5; ++n) {
        if (n > 0) asm volatile("s_waitcnt vmcnt(4)" ::: "memory");
        SBAR();
        long kf[8];
#pragma unroll
        for (int s = 0; s < 8; ++s) kf[s] = *(const LAS long*)(krd + ((16 * s) ^ kx));
        asm volatile("s_waitcnt lgkmcnt(0)" ::: "memory"); SBAR();
        unsigned toff[4];
        if (n < 4 || HN) {
            const bf16_t* kbp = (n < 4) ? kb : nkb; const int ktq = (n < 4) ? tq0 : ntq0, kdl = (n < 4) ? dil : ndil, ktl = (n < 4) ? n + 1 : 0;
            int kl = lane; asm volatile("" : "+v"(kl));
            const int kr0 = kl >> 3; const unsigned kc0 = (unsigned)(((kl & 7) ^ kr0) << 4);
            const int kt0 = ktq + kdl * (32 * ktl + kr0 - 64), kd8 = 8 * kdl;
            if (interior && n < 4) {
#pragma unroll
                for (int i = 0; i < 4; ++i) toff[i] = ((unsigned)(kt0 + i * kd8) << 7) + kc0;
            } else {
#pragma unroll
                for (int i = 0; i < 4; ++i) { int tkn = kt0 + i * kd8; tkn = tkn < 0 ? 0 : (tkn > SEQ - 1 ? SEQ - 1 : tkn); toff[i] = ((unsigned)tkn << 7) + kc0; }
            }
#pragma unroll
            for (int i = 0; i < 4; ++i) __builtin_amdgcn_global_load_lds((const unsigned*)((const GAS char*)kbp + toff[i]), (LAS unsigned*)(kbuf + i * 1024), 16, 0, 0);
        }
        f32x16 p;
#pragma unroll
        for (int r = 0; r < 16; ++r) p[r] = 0.f;
#pragma unroll
        for (int s = 0; s < 8; ++s) p = __builtin_amdgcn_mfma_f32_32x32x16_fp8_fp8(kf[s], q8[s], p, 0, 0, 0);
        const float relb = (float)(32 * n + 4 * hi - 64 - r32) - 8.0f;
#define AT_CR(r) ((float)(((r) & 3) + 8 * ((r) >> 2) + 8))
        float tmax = -1e30f;
        if (interior && n == 2) {
#pragma unroll
            for (int r = 0; r < 16; ++r) { const float rel = relb + AT_CR(r); p[r] = p[r] - sl * fabsf(rel); tmax = fmaxf(tmax, p[r]); }
        } else if (interior) {
            const float ssl = (n < 2) ? sl : -sl;
            if (n == 0) {
#pragma unroll
                for (int r = 0; r < 16; ++r) { const float rel = relb + AT_CR(r); const float v = __builtin_fmaf(ssl, rel, p[r]); p[r] = (rel >= -64.f) ? v : -1e30f; tmax = fmaxf(tmax, p[r]); }
            } else if (n == 4) {
#pragma unroll
                for (int r = 0; r < 16; ++r) { const float rel = relb + AT_CR(r); const float v = __builtin_fmaf(ssl, rel, p[r]); p[r] = (rel <= 64.f) ? v : -1e30f; tmax = fmaxf(tmax, p[r]); }
            } else {
#pragma unroll
                for (int r = 0; r < 16; ++r) { const float rel = relb + AT_CR(r); p[r] = __builtin_fmaf(ssl, rel, p[r]); tmax = fmaxf(tmax, p[r]); }
            }
        } else {
#pragma unroll
            for (int r = 0; r < 16; ++r) { const float rel = relb + AT_CR(r); const bool ok = (rel >= lo_i) && (rel <= hi_i);
                p[r] = ok ? p[r] - sl * fabsf(rel) : -1e30f; tmax = fmaxf(tmax, p[r]); }
        }
#undef AT_CR
        { auto rr = __builtin_amdgcn_permlane32_swap(__float_as_uint(tmax), __float_as_uint(tmax), false, false); tmax = fmaxf(__uint_as_float(rr[0]), __uint_as_float(rr[1])); }
        float mn = m_run, alpha = 1.f;
        if (!__all(tmax - m_run <= AT_THR)) { mn = fmaxf(m_run, tmax); alpha = __builtin_amdgcn_exp2f(m_run - mn); m_run = mn;
            if (n > 0) {
#pragma unroll
            for (int d0 = 0; d0 < 4; ++d0)
#pragma unroll
                for (int r = 0; r < 16; ++r) oT[d0][r] *= alpha; } }
        float ps = 0.f;
#pragma unroll
        for (int r = 0; r < 16; ++r) { p[r] = __builtin_amdgcn_exp2f(p[r] - mn); ps += p[r]; }
        { auto rr = __builtin_amdgcn_permlane32_swap(__float_as_uint(ps), __float_as_uint(ps), false, false); ps = __uint_as_float(rr[0]) + __uint_as_float(rr[1]); }
        l_run = l_run * alpha + ps;
        long pa0, pa1;
#define AT_PK8(P, BASE, OUT) do { const unsigned a4 = pg8::pk_fp8x4((f32x4){P[BASE + 0], P[BASE + 1], P[BASE + 2], P[BASE + 3]}), b4 = pg8::pk_fp8x4((f32x4){P[BASE + 4], P[BASE + 5], P[BASE + 6], P[BASE + 7]}); \
        auto r0 = __builtin_amdgcn_permlane32_swap(a4, b4, false, false); OUT = (long)(((unsigned long long)r0[1] << 32) | (unsigned long long)r0[0]); } while (0)
        AT_PK8(p, 0, pa0); AT_PK8(p, 8, pa1);
#undef AT_PK8
        if (n < 4 || HN) asm volatile("s_waitcnt vmcnt(4)" ::: "memory");
        else asm volatile("s_waitcnt vmcnt(0)" ::: "memory");
        SBAR();
        {
            int vl_ = lane; asm volatile("" : "+v"(vl_));
            const int vg = vl_ & 15, vgrp = vl_ >> 4, vr = TRB8_MAP ? (vg & 7) : (vg >> 1), vc = TRB8_MAP ? (vg >> 3) : (vg & 1);
            const unsigned vb0 = (unsigned)(uintptr_t)vbuf + (unsigned)((8 * (vgrp >> 1) + vr) * 128 + 8 * vc);
            long vf[4][2];
#define AT_RD8(D0) do { const unsigned va_ = vb0 + (unsigned)((((2 * D0 + (vgrp & 1)) ^ vr) & 7) << 4); vf[D0][0] = tr8_read<0>(va_); vf[D0][1] = tr8_read<2048>(va_); } while (0)
            AT_RD8(0); AT_RD8(1); AT_RD8(2); AT_RD8(3);
#undef AT_RD8
            asm volatile("s_waitcnt lgkmcnt(0)" ::: "memory"); SBAR();
            if (n < 4) {
#pragma unroll
                for (int i = 0; i < 4; ++i) __builtin_amdgcn_global_load_lds((const unsigned*)((const GAS char*)vb + toff[i]), (LAS unsigned*)(vbuf + i * 1024), 16, 0, 0); }
#pragma unroll
            for (int d0 = 0; d0 < 4; ++d0) {
                oT[d0] = __builtin_amdgcn_mfma_f32_32x32x16_fp8_fp8(vf[d0][0], pa0, oT[d0], 0, 0, 0);
                oT[d0] = __builtin_amdgcn_mfma_f32_32x32x16_fp8_fp8(vf[d0][1], pa1, oT[d0], 0, 0, 0); }
        }
    }
    if (HN) at_load_q(qr, nqb, ntq0, ndil, lane);
    const int tq = tq0 + dil * r32;
    v4u a0[8], a1v[8];
    if (FINAL) {
#pragma unroll
        for (int i = 0; i < 8; ++i) { const int row = 4 * i + rr0, c = cs ^ (row & 15); const size_t off = (size_t)(tq0 + dil * row) * 128 + 8 * c;
            a0[i] = __builtin_nontemporal_load((const GAS v4u*)(part0 + off)); a1v[i] = __builtin_nontemporal_load((const GAS v4u*)(part1 + off)); } }
    float osc, c1 = 0.f, c2 = 0.f;
    if (!FINAL) { osc = 1.0f / l_run; if (hi == 0) *(GAS f32x2*)(ml + (size_t)tq * 2) = (f32x2){m_run, l_run}; }
    else {
        const f32x2 s1 = st1, s2 = st2;
        const float M = fmaxf(fmaxf(s1.x, s2.x), m_run);
        const float a1 = __builtin_amdgcn_exp2f(s1.x - M) * s1.y, a2 = __builtin_amdgcn_exp2f(s2.x - M) * s2.y, a3 = __builtin_amdgcn_exp2f(m_run - M);
        const float inv = 1.0f / (a1 + a2 + a3 * l_run);
        c1 = a1 * inv; c2 = a2 * inv; osc = a3 * inv;
    }
    {
        LAS unsigned char* wrow = vbuf + r32 * 256 + hi * 8; const int qx = r32 & 15;
#pragma unroll
        for (int d0 = 0; d0 < 4; ++d0)
#pragma unroll
            for (int g4 = 0; g4 < 4; ++g4) { u32x2 w; w.x = cvtpk(oT[d0][4 * g4] * osc, oT[d0][4 * g4 + 1] * osc); w.y = cvtpk(oT[d0][4 * g4 + 2] * osc, oT[d0][4 * g4 + 3] * osc);
                *(LAS u32x2*)(wrow + (((4 * d0 + g4) ^ qx) << 4)) = w; }
    }
    asm volatile("s_waitcnt lgkmcnt(0)" ::: "memory"); SBAR();
    if (!FINAL) {
#pragma unroll
        for (int i = 0; i < 8; ++i) a0[i] = *(const LAS v4u*)(vbuf + (4 * i + rr0) * 256 + cs * 16);
#pragma unroll
        for (int i = 0; i < 8; ++i) { const int row = 4 * i + rr0, c = cs ^ (row & 15);
            *(GAS v4u*)(part + (size_t)(tq0 + dil * row) * 128 + 8 * c) = a0[i]; }
    } else {
#pragma unroll
        for (int i = 0; i < 8; ++i) { const int row = 4 * i + rr0, c = cs ^ (row & 15);
            const float w1 = __shfl(c1, row), w2 = __shfl(c2, row);
            const v4u o = *(const LAS v4u*)(vbuf + row * 256 + cs * 16);
            float f8[8];
#define AT_MIX(F, J) do { f8[2 * J] = w1 * bf2f(a0[i].F & 0xffffu) + w2 * bf2f(a1v[i].F & 0xffffu) + bf2f(o.F & 0xffffu); \
                f8[2 * J + 1] = w1 * bf2f(a0[i].F >> 16) + w2 * bf2f(a1v[i].F >> 16) + bf2f(o.F >> 16); } while (0)
            AT_MIX(x, 0); AT_MIX(y, 1); AT_MIX(z, 2); AT_MIX(w, 3);
#undef AT_MIX
            u32x2 r8; r8.x = pg8::pk_fp8x4((f32x4){f8[0], f8[1], f8[2], f8[3]}); r8.y = pg8::pk_fp8x4((f32x4){f8[4], f8[5], f8[6], f8[7]});
            *(GAS u32x2*)((GAS unsigned char*)yout + (size_t)(tq0 + dil * row) * 3072 + 8 * c) = r8; }
    }
    asm volatile("s_waitcnt lgkmcnt(0)" ::: "memory"); SBAR();
    if (HN) at_dma_v(vbuf, nvb, ntq0, ndil, 0, lane);
}

struct Args { const float* in[9]; float* out; unsigned char* ws; };

__global__ void __launch_bounds__(NWAVES * 64, 2) mk_fwd(Args args) {
    extern __shared__ __attribute__((aligned(16))) unsigned char lds_raw[];
    LAS unsigned char* lds = (LAS unsigned char*)lds_raw;
    volatile LAS unsigned* MISC = (volatile LAS unsigned*)(lds + MISC_OFF);
    const int tid = threadIdx.x, lane = tid & 63, wave = __builtin_amdgcn_readfirstlane(tid >> 6);
    const int G = gridDim.x, gw = blockIdx.x * NWAVES + wave, NGW = G * NWAVES;
    unsigned char* ws = args.ws;
    const float* x = args.in[0]; const float* g_mix = args.in[1]; const float* w_in = args.in[2]; const float* w_f = args.in[3];
    const float* w_out = args.in[4]; const float* g_mlp = args.in[5]; const float* w_up = args.in[6]; const float* w_down = args.in[7]; const float* g_fin = args.in[8];
    float* out = args.out;
    float* ssq1 = (float*)(ws + WS_SSQ1); float* ssq2 = (float*)(ws + WS_SSQ2); float* inv0 = (float*)(ws + WS_INV0);
    bf16_t* abt = (bf16_t*)(ws + WS_ABT);
    bf16_t* wint = (bf16_t*)(ws + WS_WINT); bf16_t* wo = (bf16_t*)(ws + WS_WO); bf16_t* wup = (bf16_t*)(ws + WS_WUP); bf16_t* wd = (bf16_t*)(ws + WS_WD);
    bf16_t* h1b = (bf16_t*)(ws + WS_H1B); bf16_t* xb = (bf16_t*)(ws + WS_XB); bf16_t* y = (bf16_t*)(ws + WS_Y);
    bf16_t* qkv = (bf16_t*)(ws + WS_Q); bf16_t* zt = (bf16_t*)(ws + WS_ZT); bf16_t* trig2 = (bf16_t*)(ws + WS_TRIG2); bf16_t* abuf = (bf16_t*)(ws + WS_A);

    for (int u = tid; u < (LDS_BYTES - LDSCTL_OFF) / 4; u += NWAVES * 64) ((LAS unsigned*)(lds + LDSCTL_OFF))[u] = 0u;
    __syncthreads();
    XcdBarrier bar = xcd_barrier_post((unsigned*)(ws + WS_CTL) + CW_BAR, MISC + 8);

    {
        LAS float* scr = (LAS float*)(lds + wave * 16384);
        for (int m = gw; m < T; m += NGW) {
            const GAS f32x4* xr = (const GAS f32x4*)(x + (size_t)m * DM) + lane; f32x4 v[8]; float s = 0.f;
#pragma unroll
            for (int j = 0; j < 8; ++j) { v[j] = __builtin_nontemporal_load(&xr[64 * j]); s += (v[j].x * v[j].x + v[j].y * v[j].y) + (v[j].z * v[j].z + v[j].w * v[j].w); }
            s = wave_sum(s);
            if (lane == 0) { const float iv = 1.0f / sqrtf(s * (1.0f / DM) + EPS); inv0[m] = iv; }
            GAS unsigned long long* o8 = (GAS unsigned long long*)(xb + (size_t)m * DM) + lane;
#pragma unroll
            for (int j = 0; j < 8; ++j) o8[64 * j] = (unsigned long long)pk2(v[j].x, v[j].y) | ((unsigned long long)pk2(v[j].z, v[j].w) << 32);
        }
        {
            LAS unsigned* ctu = (LAS unsigned*)(scr + 2304); LAS unsigned* stu = (LAS unsigned*)(scr + 2560);
            for (int j = lane; j < 256; j += 64) { ctu[j] = f2bf(cospif((float)j / 128.0f)); stu[j] = f2bf(sinpif((float)j / 128.0f)); }
            LDS_WAIT();
            typedef float f32x4v __attribute__((ext_vector_type(4)));
            for (int it = gw; it < 4 * 16 * 16; it += NGW) {
                const int cb = it & 15, ebk = (it >> 4) & 15, g = it >> 8, i16 = lane & 15, kg = lane >> 4, c = cb * 16 + i16;
                const float* wcol = w_f + (size_t)g * 65536 + ebk * 16 + i16;
                f32x4v dc = {0.f, 0.f, 0.f, 0.f}, ds = {0.f, 0.f, 0.f, 0.f};
#pragma unroll 2
                for (int ks = 0; ks < 8; ++ks) { const int k0 = 32 * ks + 8 * kg;
                    float wv[8];
#pragma unroll
                    for (int j = 0; j < 8; ++j) wv[j] = wcol[(size_t)(k0 + j) * 256];
                    v4u bw, ac, as;
                    bw.x = pg8::cvt_pk_bf16(wv[0], wv[1]); bw.y = pg8::cvt_pk_bf16(wv[2], wv[3]); bw.z = pg8::cvt_pk_bf16(wv[4], wv[5]); bw.w = pg8::cvt_pk_bf16(wv[6], wv[7]);
#define ABT_PH(J) ((c * (k0 + (J))) & 255)
                    ac.x = ctu[ABT_PH(0)] | (ctu[ABT_PH(1)] << 16); ac.y = ctu[ABT_PH(2)] | (ctu[ABT_PH(3)] << 16); ac.z = ctu[ABT_PH(4)] | (ctu[ABT_PH(5)] << 16); ac.w = ctu[ABT_PH(6)] | (ctu[ABT_PH(7)] << 16);
                    as.x = stu[ABT_PH(0)] | (stu[ABT_PH(1)] << 16); as.y = stu[ABT_PH(2)] | (stu[ABT_PH(3)] << 16); as.z = stu[ABT_PH(4)] | (stu[ABT_PH(5)] << 16); as.w = stu[ABT_PH(6)] | (stu[ABT_PH(7)] << 16);
#undef ABT_PH
                    dc = __builtin_amdgcn_mfma_f32_16x16x32_bf16(__builtin_bit_cast(bf16x8, ac), __builtin_bit_cast(bf16x8, bw), dc, 0, 0, 0);
                    ds = __builtin_amdgcn_mfma_f32_16x16x32_bf16(__builtin_bit_cast(bf16x8, as), __builtin_bit_cast(bf16x8, bw), ds, 0, 0, 0); }
                bf16_t* o = abt + ((size_t)g * 512 + 2 * (ebk * 16 + i16)) * 256 + cb * 16 + 4 * kg;
                *(GAS u32x2*)o = (u32x2){pg8::cvt_pk_bf16(dc[0], dc[1]), pg8::cvt_pk_bf16(dc[2], dc[3])};
                *(GAS u32x2*)(o + 256) = (u32x2){pg8::cvt_pk_bf16(ds[0], ds[1]), pg8::cvt_pk_bf16(ds[2], ds[3])};
            }
        }
        for (int it = gw * 64 + lane; it < 256 * 512 / 8; it += NGW * 64) {
            const int k0 = (it & 63) * 8, s2p = it >> 6; float v[8];
#pragma unroll
            for (int e = 0; e < 8; ++e) { const int k = k0 + e, s2 = k >> 1; const float a2 = (float)((s2 * s2p) & 255) * (1.0f / 128.0f);
                v[e] = ((k & 1) ? sinpif(a2) : cospif(a2)) * (1.0f / 1024.0f); }
            v4u o; o.x = pk2(v[0], v[1]); o.y = pk2(v[2], v[3]); o.z = pk2(v[4], v[5]); o.w = pk2(v[6], v[7]);
            *(GAS v4u*)(trig2 + (size_t)it * 8) = o;
        }
        {
            constexpr int I_QKV = (2048 / 64) * (3072 / 32), I_U = (2048 / 64) * (1024 / 32), I_O = (2048 / 64) * (2048 / 32), I_UP = (2048 / 64) * (8192 / 32), I_D = (8192 / 64) * (2048 / 32);
            constexpr int NITEMS = I_QKV + I_U + I_O + I_UP + I_D;
            for (int it = gw; it < NITEMS; it += NGW) {
                int r = it;
                if (r < I_QKV) { p0_transpose_item(w_in, 4096, 1024, 2048, 3072, g_mix, wint, scr, r, lane); continue; } r -= I_QKV;
                if (r < I_U) { p0_transpose_item(w_in, 4096, 0, 2048, 1024, g_mix, wint + (size_t)3072 * 2048, scr, r, lane); continue; } r -= I_U;
                if (r < I_O) { p0_transpose_item_wo(w_out, wo, scr, r, lane); continue; } r -= I_O;
                if (r < I_UP) { p0_transpose_item(w_up, 8192, 0, 2048, 8192, g_mlp, wup, scr, r, lane); continue; } r -= I_UP;
                p0_transpose_item(w_down, 2048, 0, 8192, 2048, nullptr, wd, scr, r, lane);
            }
        }
    }
    xcd_barrier(bar, wave);

    {
        pg8::AddrStd g{xb, wint, 2048, 2048, 30, 0u}; pg8::StaticOrder S; S.init(T, 4096, G, (int)blockIdx.x, WGM_Q);
        pg8::EpiB<0, 1, false, true> E{qkv, 1024, inv0, nullptr, 1024, (size_t)T * 1024, QSCALE};
        pg8::gemm_phase<pg8::EpiB<0, 1, false, true>, pg8::StaticOrder, pg8::AddrStd, true>(lds, 2048, g, S, E, wave);
    }
    xcd_barrier(bar, wave);
    {
        pg8::AddrF1u g{abt, qkv + (size_t)3 * T * 1024}; pg8::StaticOrder S; S.init(2048, T, G, (int)blockIdx.x, WGM_F);
        pg8::EpiDft1 E{zt, lds};
        const int nu = (S.nwg - (int)blockIdx.x + G - 1) / G;
#pragma unroll 1
        for (int i = 0; i < nu; ++i) { pg8::OneUnit o; (void)S.next(i, o.u);
            pg8::gemm_phase<pg8::EpiDft1, pg8::OneUnit, pg8::AddrF1u, true>(lds, 256, g, o, E, wave); }
    }

    bf16_t* const part0 = (bf16_t*)out; bf16_t* const part1 = part0 + (size_t)T * 1024;
    float* const mlb0 = (float*)((unsigned char*)out + 64 * MiB); float* const mlb1 = mlb0 + (size_t)T * NH * 2;
    const int vwave = (G % 8 == 0) ? (int)(((blockIdx.x & 7) * (G >> 3) + (blockIdx.x >> 3)) * NWAVES + wave) : gw;
    {
        LAS unsigned char* wl = lds + wave * 16384;
        int lna = (int)lane_id_fresh(); asm volatile("" : "+v"(lna));
        constexpr int NU = NB * NH * 256;
#define AT_DEC_AB(U_, QP, KP, VP, TQ, DL, SL, PP, MP) do { const int pr_ = (U_) >> 8, sl_ = (U_) & 255, h_ = pr_ & 7; const size_t hb_ = (size_t)(pr_ >> 3) * SEQ * 1024 + h_ * 128; \
            const size_t hm_ = (size_t)pr_ * SEQ * 128; QP = qkv + hm_; KP = qkv + (size_t)T * 1024 + hm_ / 2; VP = qkv + (size_t)2 * T * 1024 + hm_ / 2; const float s2_ = exp2f(-(float)(h_ + 1)) * LOG2E; \
            if (sl_ < 128) { DL = 16; TQ = 512 * (sl_ >> 4) + (sl_ & 15); PP = part0 + hm_; MP = mlb0 + (size_t)pr_ * SEQ * 2; } \
            else { const int s_ = sl_ - 128; DL = 4; TQ = 128 * (s_ >> 2) + (s_ & 3); PP = part1 + hm_; MP = mlb1 + (size_t)pr_ * SEQ * 2; } SL = s2_ * (float)DL; } while (0)
        int U = vwave;
        if (U < NU) {
            const bf16_t *cq, *ck, *cv, *nq, *nk, *nv; bf16_t *cp, *np_; float *cm, *nm; int ctq, cdl, ntq = 0, ndl = 1; float csl, nsl = 0.f;
            AT_DEC_AB(U, cq, ck, cv, ctq, cdl, csl, cp, cm);
            nq = cq; nk = ck; nv = cv; np_ = cp; nm = cm;
            bf16x8 qr[8];
            at_unit_prologue(wl, qr, cq, ck, cv, ctq, cdl, lna);
#pragma unroll 1
            for (;;) {
                const int Un = U + NGW; const bool hn = Un < NU;
                if (hn) AT_DEC_AB(Un, nq, nk, nv, ntq, ndl, nsl, np_, nm);
                attn_unit(false, hn, wl, cq, ck, cv, ctq, cdl, csl, qr, nq, nk, nv, ntq, ndl, cp, cm, nullptr, nullptr, nullptr, nullptr, nullptr, lna);
                if (!hn) break;
                U = Un; cq = nq; ck = nk; cv = nv; ctq = ntq; cdl = ndl; csl = nsl; cp = np_; cm = nm;
            }
        }
#undef AT_DEC_AB
    }
    xcd_barrier(bar, wave);

    {
        LAS unsigned char* wl = lds + wave * 16384;
        int lna = (int)lane_id_fresh(); asm volatile("" : "+v"(lna));
        constexpr int NU = NB * NH * 128;
#define AT_DEC_C(U_, QP, KP, VP, TQ, SL, P0, P1, M0, M1, YP) do { const int pr_ = (U_) >> 7, h_ = pr_ & 7, b_ = pr_ >> 3; const size_t hb_ = (size_t)b_ * SEQ * 1024 + h_ * 128; \
            const size_t hm_ = (size_t)pr_ * SEQ * 128; QP = qkv + hm_; KP = qkv + (size_t)T * 1024 + hm_ / 2; VP = qkv + (size_t)2 * T * 1024 + hm_ / 2; SL = exp2f(-(float)(h_ + 1)) * LOG2E; TQ = 32 * ((U_) & 127); \
            P0 = part0 + hm_; P1 = part1 + hm_; M0 = mlb0 + (size_t)pr_ * SEQ * 2; M1 = mlb1 + (size_t)pr_ * SEQ * 2; YP = (bf16_t*)((unsigned char*)y + (size_t)b_ * SEQ * 3072 + 2048 + h_ * 128); } while (0)
        int U = vwave;
        if (U < NU) {
            const bf16_t *cq, *ck, *cv, *nq, *nk, *nv, *c0, *c1, *n0, *n1; const float *cm0, *cm1, *nm0, *nm1; bf16_t *cy, *ny; int ctq, ntq = 0; float csl, nsl = 0.f;
            AT_DEC_C(U, cq, ck, cv, ctq, csl, c0, c1, cm0, cm1, cy);
            nq = cq; nk = ck; nv = cv; n0 = c0; n1 = c1; nm0 = cm0; nm1 = cm1; ny = cy;
            bf16x8 qr[8];
            at_unit_prologue(wl, qr, cq, ck, cv, ctq, 1, lna);
#pragma unroll 1
            for (;;) {
                const int Un = U + NGW; const bool hn = Un < NU;
                if (hn) AT_DEC_C(Un, nq, nk, nv, ntq, nsl, n0, n1, nm0, nm1, ny);
                attn_unit(true, hn, wl, cq, ck, cv, ctq, 1, csl, qr, nq, nk, nv, ntq, 1, nullptr, nullptr, c0, c1, cm0, cm1, cy, lna);
                if (!hn) break;
                U = Un; cq = nq; ck = nk; cv = nv; ctq = ntq; csl = nsl; c0 = n0; c1 = n1; cm0 = nm0; cm1 = nm1; cy = ny;
            }
        }
#undef AT_DEC_C
        asm volatile("s_waitcnt vmcnt(0)" ::: "memory");
        __syncthreads();
    }

    {
        pg8::AddrF2 g{trig2, zt}; pg8::StaticOrder S; S.init(64 * 256, 1024, G, (int)blockIdx.x);
        pg8::EpiY E{y, 1536};
        pg8::gemm_phase<pg8::EpiY, pg8::StaticOrder, pg8::AddrF2, true>(lds, 512, g, S, E, wave);
    }
    xcd_barrier(bar, wave);

    {
        pg8::AddrStd g{y, wo, 1536, 1536, 30, 0u}; pg8::StaticOrder S; S.init(T, 2048, G, (int)blockIdx.x, WGM_O);
        pg8::EpiResXb E{xb, h1b, ssq1, 2048, 1.0f / 32.0f};
        pg8::gemm_phase<pg8::EpiResXb, pg8::StaticOrder, pg8::AddrStd, true, 16>(lds, 1536, g, S, E, wave);
    }
    xcd_barrier(bar, wave);

    const bool fuse7 = G >= (T / 2 / 256) * (DM / 256);
    for (int half = 0; half < 2; ++half) {
        const size_t roff = (size_t)half * (T / 2);
        bf16_t* const ab = (fuse7 && half) ? (bf16_t*)(ws + WS_XB) : abuf;
        {
            pg8::AddrStd g{h1b + roff * DM, wup, 2048, 2048, 30, 0u}; pg8::StaticOrder S; S.init(T / 2, DFF, G, (int)blockIdx.x, WGM_U);
            pg8::EpiB<2, 2, false> E{ab, DFF, ssq1 + roff, nullptr, 0, 0, 1.f};
            pg8::gemm_phase<pg8::EpiB<2, 2, false>, pg8::StaticOrder, pg8::AddrStd, true>(lds, 2048, g, S, E, wave);
        }
        xcd_barrier(bar, wave);
        if (fuse7) {
            pg8::AddrStd g{ab, wd, DFF, DFF, 30, 0u}; pg8::StaticOrder S; S.init(T / 2, 2048, G, (int)blockIdx.x, WGM_D);
            pg8::EpiResOut E{h1b + roff * DM, ssq2 + roff, out + roff * DM, g_fin, (unsigned*)(ws + WS_CTL) + CW_EXCH + half * 1024, (unsigned*)(ws + WS_CTL) + CW_BAR + XB_TMO, 2048, 32u};
            pg8::gemm_phase<pg8::EpiResOut, pg8::StaticOrder, pg8::AddrStd, true>(lds, DFF, g, S, E, wave);
        } else {
            pg8::AddrStd g{abuf, wd, DFF, DFF, 30, 0u}; pg8::StaticOrder S; S.init(T / 2, 2048, G, (int)blockIdx.x, WGM_D);
            pg8::EpiResB E{h1b + roff * DM, ssq2 + roff, 2048};
            pg8::gemm_phase<pg8::EpiResB, pg8::StaticOrder, pg8::AddrStd, true>(lds, DFF, g, S, E, wave);
            xcd_barrier(bar, wave);
        }
    }
    if (fuse7) return;

    const int lane7 = (int)lane_id_fresh();
    for (int m = gw; m < T; m += NGW) {
        const GAS v4u* hr = (const GAS v4u*)(h1b + (size_t)m * DM) + lane7; GAS f32x4* xr = (GAS f32x4*)(out + (size_t)m * DM) + 2 * lane7; const GAS f32x4* gr = (const GAS f32x4*)g_fin + 2 * lane7;
        const float inv = 1.0f / sqrtf(ssq2[m] * (1.0f / DM) + EPS);
#pragma unroll
        for (int j = 0; j < 4; ++j) { const v4u b = __builtin_nontemporal_load(&hr[64 * j]); const f32x4 g0 = gr[128 * j], g1 = gr[128 * j + 1];
            __builtin_nontemporal_store((f32x4){bf2f(b.x & 0xffffu) * inv * g0.x, bf2f(b.x >> 16) * inv * g0.y, bf2f(b.y & 0xffffu) * inv * g0.z, bf2f(b.y >> 16) * inv * g0.w}, &xr[128 * j]);
            __builtin_nontemporal_store((f32x4){bf2f(b.z & 0xffffu) * inv * g1.x, bf2f(b.z >> 16) * inv * g1.y, bf2f(b.w & 0xffffu) * inv * g1.z, bf2f(b.w >> 16) * inv * g1.w}, &xr[128 * j + 1]); }
    }
}

extern "C" void kernel_launch(void* const* d_in, const int* in_sizes, int n_in, void* d_out, int out_size, void* d_ws, size_t ws_size, hipStream_t stream) {
    static int grid = 0;
    if (grid == 0) {
        if (n_in != 9 || in_sizes[0] != T * DM || out_size != T * DM || ws_size < WS_END) {
            fprintf(stderr, "kernel_launch: unexpected shapes: n_in %d in0 %d out %d ws %zu (need >= %zu)\n", n_in, n_in > 0 ? in_sizes[0] : -1, out_size, ws_size, (size_t)WS_END);
            grid = -1; return; }
        int dev = 0, cus = 0, per_cu = 0;
        if (hipGetDevice(&dev) != hipSuccess || hipDeviceGetAttribute(&cus, hipDeviceAttributeMultiprocessorCount, dev) != hipSuccess) { fprintf(stderr, "kernel_launch: device query failed\n"); grid = -1; return; }
        if (hipFuncSetAttribute((const void*)mk_fwd, hipFuncAttributeMaxDynamicSharedMemorySize, LDS_BYTES) != hipSuccess) { fprintf(stderr, "kernel_launch: hipFuncSetAttribute failed\n"); grid = -1; return; }
        if (hipOccupancyMaxActiveBlocksPerMultiprocessor(&per_cu, (const void*)mk_fwd, NWAVES * 64, LDS_BYTES) != hipSuccess || per_cu < 1) {
            fprintf(stderr, "kernel_launch: occupancy query reports %d workgroups per CU; need 1\n", per_cu); (void)hipGetLastError(); grid = -1; return; }
        grid = cus;
    }
    if (grid < 0) return;
    if (hipMemsetAsync((char*)d_ws + WS_CTL, 0, CTL_ZERO_BYTES, stream) != hipSuccess) { fprintf(stderr, "kernel_launch: hipMemsetAsync failed\n"); return; }
    Args a{};
    for (int i = 0; i < 9; ++i) a.in[i] = (const float*)d_in[i];
    a.out = (float*)d_out; a.ws = (unsigned char*)d_ws;
    hipLaunchKernelGGL(mk_fwd, dim3(grid), dim3(NWAVES * 64), LDS_BYTES, stream, a);
    const hipError_t le = hipPeekAtLastError();
    if (le != hipSuccess) fprintf(stderr, "kernel_launch: launch failed: %s\n", hipGetErrorName(le));
}
```

```cpp
#include <hip/hip_runtime.h>
#include <cstdio>
#include <cstdint>

constexpr int NB = 4, SEQ = 4096, DM = 2048, T = NB * SEQ, DFF = 8192;
constexpr int NH = 8;
constexpr float EPS = 1e-6f;
constexpr float LOG2E = 1.4426950408889634f;
constexpr float QSCALE = 0.08838834764831845f * LOG2E;

namespace pg8 {
#define PG8_LAS __attribute__((address_space(3)))
#define PG8_GAS __attribute__((address_space(1)))
__device__ __forceinline__ unsigned lane_id_fresh() { unsigned m = ~0u; asm volatile("" : "+s"(m)); return __builtin_amdgcn_mbcnt_hi(m, __builtin_amdgcn_mbcnt_lo(m, 0u)); }
typedef unsigned short bf16_t;
typedef short bf16x8 __attribute__((ext_vector_type(8)));
typedef float f32x4 __attribute__((ext_vector_type(4)));
typedef unsigned u32x4 __attribute__((ext_vector_type(4)));
typedef unsigned u32x2 __attribute__((ext_vector_type(2)));
constexpr int BM = 256, BK = 64, HALF = 128, HTB = HALF * BK * 2  , STAGE_BYTES = 8 * HTB, NXCD = 8, WGM = 4;

__host__ __device__ __forceinline__ int lds_byte(int r, int c) { const int st = (r >> 4) * 2 + (c >> 5), rr = r & 15, cc = c & 31, ob = rr * 64 + cc * 2; return st * 1024 + (ob ^ (((ob >> 9) & 1) << 5)); }
__host__ __device__ __forceinline__ void stage_rc(int b, int& R, int& C) { const int st = b / 1024, sb = b % 1024, swz = sb ^ (((sb >> 9) & 1) << 5); R = (st >> 1) * 16 + swz / 64; C = (st & 1) * 32 + (swz % 64) / 2; }
__host__ __device__ __forceinline__ int perm32(int rho) { const int n = rho >> 4, i = rho & 15; return 8 * (i >> 2) + 4 * n + (i & 3); }

struct Unit { int pm, pn; };
struct AddrStd {
    const bf16_t* A; const bf16_t* Bt; int lda, ldb, gshift; unsigned goff;
    __device__ __forceinline__ unsigned voffA(int R, int C) const { return (unsigned)(R * lda + C) * 2u; }
    __device__ __forceinline__ unsigned voffB(int R, int C) const { return (unsigned)(R * ldb + C) * 2u; }
    __device__ __forceinline__ size_t hA() const { return (size_t)HALF * lda * 2; }
    __device__ __forceinline__ size_t hB() const { return (size_t)HALF * ldb * 2; }
    __device__ __forceinline__ const char* a(const Unit& u) const { return (const char*)A + (size_t)u.pm * 2 * hA(); }
    __device__ __forceinline__ const char* b(const Unit& u) const { return (const char*)Bt + (size_t)u.pn * 2 * hB() + (size_t)(u.pm >> gshift) * goff; }
};
struct AddrF1u {
    const bf16_t* A; const bf16_t* Bt;
    __device__ __forceinline__ unsigned voffA(int R, int C) const { return (unsigned)(R * 256 + C) * 2u; }
    __device__ __forceinline__ unsigned voffB(int R, int C) const { return (unsigned)((256 * (R & 15) + (R >> 4)) * 1024 + C) * 2u; }
    __device__ __forceinline__ size_t hA() const { return (size_t)HALF * 256 * 2; }
    __device__ __forceinline__ size_t hB() const { return (size_t)8 * 1024 * 2; }
    __device__ __forceinline__ const char* a(const Unit& u) const { return (const char*)A + (size_t)u.pm * 2 * hA(); }
    __device__ __forceinline__ const char* b(const Unit& u) const { return (const char*)Bt + (size_t)((u.pn >> 4) * 4096 + (u.pn & 15) * 16) * 1024 * 2 + (size_t)(u.pm >> 1) * 512; }
};
struct AddrF2 {
    const bf16_t* A; const bf16_t* Bt;
    __device__ __forceinline__ unsigned voffA(int R, int C) const { return (unsigned)(R * 512 + C) * 2u; }
    __device__ __forceinline__ unsigned voffB(int R, int C) const { return (unsigned)(R * 8192 + C) * 2u; }
    __device__ __forceinline__ size_t hA() const { return (size_t)HALF * 512 * 2; }
    __device__ __forceinline__ size_t hB() const { return (size_t)HALF * 8192 * 2; }
    __device__ __forceinline__ const char* a(const Unit&) const { return (const char*)A; }
    __device__ __forceinline__ const char* b(const Unit& u) const { return (const char*)Bt + ((size_t)(((u.pm >> 4) * 1024 + u.pn * 256) * 16 + (u.pm & 15)) * 512) * 2; }
};

struct StaticOrder {
    int nM, nN, nwg, G, c, wgm;
    __host__ __device__ void init(int M, int N, int G_, int c_, int wgm_ = WGM) { nM = M / BM; nN = N / BM; nwg = nM * nN; G = G_; c = c_; wgm = wgm_; }
    __host__ __device__ bool next(int i, Unit& u) const {
        const long L = (long)i * G + c; if (L >= nwg) return false;
        int wgid = (int)L; { const int q = nwg / NXCD, r = nwg % NXCD, xcd = wgid % NXCD, off = wgid / NXCD; wgid = (xcd < r ? xcd * (q + 1) : r * (q + 1) + (xcd - r) * q) + off; }
        const int nig = wgm * nN, gid = wgid / nig, fm = gid * wgm, gsz = (nM - fm) < wgm ? (nM - fm) : wgm;
        u.pm = fm + ((wgid % nig) % gsz); u.pn = (wgid % nig) / gsz; return true;
    }
    __device__ __forceinline__ void a_ready(const Unit&) const {}
    __device__ __forceinline__ void done(const Unit&) const {}
};

__device__ __forceinline__ unsigned cvt_pk_bf16(float lo, float hi) { unsigned r; asm volatile("v_cvt_pk_bf16_f32 %0, %1, %2" : "=v"(r) : "v"(lo), "v"(hi)); return r; }

__device__ __forceinline__ unsigned pk_fp8x4(const f32x4 v) { int r = __builtin_amdgcn_cvt_pk_fp8_f32(v[0], v[1], 0, false); r = __builtin_amdgcn_cvt_pk_fp8_f32(v[2], v[3], r, true); return (unsigned)r; }
template <int ACT, int RS, bool CS, bool HM = false> struct EpiB {
    static constexpr bool PERM = true, AFTER_DRAIN = false;
    bf16_t* O; int ldc; const float* rs; const float* cs; int split_cols; size_t split_stride; float scale0;
    __device__ __forceinline__ void operator()(const f32x4 (&acc)[2][2][4][2], const Unit& u, int wr, int wc, int fr, int fq) const {
        { int l_ = (int)lane_id_fresh(); asm volatile("" : "+v"(l_)); fr = l_ & 15; fq = l_ >> 4; }
        const int row0 = u.pm * BM + wr * 64 + fr; int colt = u.pn * BM; bf16_t* base = O;
        float sc = 1.f; bool hm = false, k8 = false; if (split_cols) { const int t = colt / split_cols; base += (size_t)t * split_stride; colt -= t * split_cols; if (t == 0) sc = scale0; hm = HM && t < 3; k8 = HM && (t == 1 || t == 2); }
        const int col0 = colt + wc * 32 + 8 * fq, gcol0 = u.pn * BM + wc * 32 + 8 * fq;
        const size_t bstep = hm ? (size_t)4096 * 128 : (size_t)HALF;
        f32x4 cv[2][2];
#pragma unroll
        for (int bj = 0; bj < 2; ++bj)
#pragma unroll
            for (int n = 0; n < 2; ++n) cv[bj][n] = CS ? *(const f32x4*)(cs + gcol0 + bj * HALF + 4 * n) : (f32x4){1.f, 1.f, 1.f, 1.f};
        float rsv[2][4];
#pragma unroll
        for (int ai = 0; ai < 2; ++ai)
#pragma unroll
            for (int m = 0; m < 4; ++m) rsv[ai][m] = RS ? rs[row0 + ai * HALF + m * 16] : 1.0f;
#pragma unroll
        for (int ai = 0; ai < 2; ++ai)
#pragma unroll
            for (int m = 0; m < 4; ++m) { const int r = row0 + ai * HALF + m * 16;
                bf16_t* rowp = hm ? base + ((size_t)((r >> 12) * 8 + (colt >> 7)) * 4096 + (r & 4095)) * 128 + wc * 32 + 8 * fq : base + (size_t)r * ldc + col0;
                float rv = sc; if (RS == 1) rv *= rsv[ai][m]; if (RS == 2) rv *= __builtin_amdgcn_rsqf(rsv[ai][m] * (1.0f / DM) + EPS);
#pragma unroll
                for (int bj = 0; bj < 2; ++bj) { f32x4 v0 = acc[ai][bj][m][0] * rv, v1 = acc[ai][bj][m][1] * rv;
                    if (CS) { v0 = v0 * cv[bj][0]; v1 = v1 * cv[bj][1]; }
                    if (ACT == 2) {
#pragma unroll
                        for (int e = 0; e < 4; ++e) { float a = v0[e] > 0.f ? v0[e] : 0.f, b = v1[e] > 0.f ? v1[e] : 0.f; v0[e] = a * a; v1[e] = b * b; } }
                    if (k8) {
                        u32x2 w8; w8.x = pk_fp8x4(v0); w8.y = pk_fp8x4(v1);
                        *(u32x2*)((unsigned char*)base + ((size_t)((r >> 12) * 8 + (colt >> 7) + bj) * 4096 + (r & 4095)) * 128 + wc * 32 + 8 * fq) = w8;
                    } else {
                    u32x4 w; w.x = cvt_pk_bf16(v0[0], v0[1]); w.y = cvt_pk_bf16(v0[2], v0[3]); w.z = cvt_pk_bf16(v1[0], v1[1]); w.w = cvt_pk_bf16(v1[2], v1[3]);
                    *(u32x4*)(rowp + bj * bstep) = w; } } }
    }
};
struct EpiResXb {
    static constexpr bool PERM = true, AFTER_DRAIN = false;
    const bf16_t* xb; bf16_t* outb; float* ssq; int ldc; float asc;
    __device__ __forceinline__ void operator()(const f32x4 (&acc)[2][2][4][2], const Unit& u, int wr, int wc, int fr, int fq) const {
        { int l_ = (int)lane_id_fresh(); asm volatile("" : "+v"(l_)); fr = l_ & 15; fq = l_ >> 4; }
        const int row0 = u.pm * BM + wr * 64 + fr, col0 = u.pn * BM + wc * 32 + 8 * fq;
        u32x4 bv[2][4][2];
#pragma unroll
        for (int ai = 0; ai < 2; ++ai)
#pragma unroll
            for (int m = 0; m < 4; ++m) { const size_t off = (size_t)(row0 + ai * HALF + m * 16) * ldc + col0;
#pragma unroll
                for (int bj = 0; bj < 2; ++bj) bv[ai][m][bj] = __builtin_nontemporal_load((const u32x4*)(xb + off + bj * HALF)); }
#pragma unroll
        for (int ai = 0; ai < 2; ++ai)
#pragma unroll
            for (int m = 0; m < 4; ++m) { const int r = row0 + ai * HALF + m * 16; const size_t off = (size_t)r * ldc + col0; float s = 0.f;
#pragma unroll
                for (int bj = 0; bj < 2; ++bj) { const u32x4 b = bv[ai][m][bj];
                    f32x4 o0, o1;
                    o0[0] = __builtin_fmaf(acc[ai][bj][m][0][0], asc, __builtin_bit_cast(float, b.x << 16)); o0[1] = __builtin_fmaf(acc[ai][bj][m][0][1], asc, __builtin_bit_cast(float, b.x & 0xffff0000u));
                    o0[2] = __builtin_fmaf(acc[ai][bj][m][0][2], asc, __builtin_bit_cast(float, b.y << 16)); o0[3] = __builtin_fmaf(acc[ai][bj][m][0][3], asc, __builtin_bit_cast(float, b.y & 0xffff0000u));
                    o1[0] = __builtin_fmaf(acc[ai][bj][m][1][0], asc, __builtin_bit_cast(float, b.z << 16)); o1[1] = __builtin_fmaf(acc[ai][bj][m][1][1], asc, __builtin_bit_cast(float, b.z & 0xffff0000u));
                    o1[2] = __builtin_fmaf(acc[ai][bj][m][1][2], asc, __builtin_bit_cast(float, b.w << 16)); o1[3] = __builtin_fmaf(acc[ai][bj][m][1][3], asc, __builtin_bit_cast(float, b.w & 0xffff0000u));
                    s += ((o0[0] * o0[0] + o0[1] * o0[1]) + (o0[2] * o0[2] + o0[3] * o0[3])) + ((o1[0] * o1[0] + o1[1] * o1[1]) + (o1[2] * o1[2] + o1[3] * o1[3]));
                    u32x4 w; w.x = cvt_pk_bf16(o0[0], o0[1]); w.y = cvt_pk_bf16(o0[2], o0[3]); w.z = cvt_pk_bf16(o1[0], o1[1]); w.w = cvt_pk_bf16(o1[2], o1[3]);
                    *(u32x4*)(outb + off + bj * HALF) = w; }
                s += __shfl_xor(s, 16); s += __shfl_xor(s, 32);
                if (fq == 0) atomicAdd(ssq + r, s); }
    }
};
struct EpiResB {
    static constexpr bool PERM = true, AFTER_DRAIN = false;
    bf16_t* hb; float* ssq; int ldc;
    __device__ __forceinline__ void operator()(const f32x4 (&acc)[2][2][4][2], const Unit& u, int wr, int wc, int fr, int fq) const {
        { int l_ = (int)lane_id_fresh(); asm volatile("" : "+v"(l_)); fr = l_ & 15; fq = l_ >> 4; }
        const int row0 = u.pm * BM + wr * 64 + fr, col0 = u.pn * BM + wc * 32 + 8 * fq;
        u32x4 bv[2][4][2];
#pragma unroll
        for (int ai = 0; ai < 2; ++ai)
#pragma unroll
            for (int m = 0; m < 4; ++m) { const size_t off = (size_t)(row0 + ai * HALF + m * 16) * ldc + col0;
#pragma unroll
                for (int bj = 0; bj < 2; ++bj) bv[ai][m][bj] = *(const u32x4*)(hb + off + bj * HALF); }
#pragma unroll
        for (int ai = 0; ai < 2; ++ai)
#pragma unroll
            for (int m = 0; m < 4; ++m) { const int r = row0 + ai * HALF + m * 16; const size_t off = (size_t)r * ldc + col0; float s = 0.f;
#pragma unroll
                for (int bj = 0; bj < 2; ++bj) { const u32x4 b = bv[ai][m][bj];
                    f32x4 o0, o1;
                    o0[0] = __builtin_bit_cast(float, b.x << 16) + acc[ai][bj][m][0][0]; o0[1] = __builtin_bit_cast(float, b.x & 0xffff0000u) + acc[ai][bj][m][0][1];
                    o0[2] = __builtin_bit_cast(float, b.y << 16) + acc[ai][bj][m][0][2]; o0[3] = __builtin_bit_cast(float, b.y & 0xffff0000u) + acc[ai][bj][m][0][3];
                    o1[0] = __builtin_bit_cast(float, b.z << 16) + acc[ai][bj][m][1][0]; o1[1] = __builtin_bit_cast(float, b.z & 0xffff0000u) + acc[ai][bj][m][1][1];
                    o1[2] = __builtin_bit_cast(float, b.w << 16) + acc[ai][bj][m][1][2]; o1[3] = __builtin_bit_cast(float, b.w & 0xffff0000u) + acc[ai][bj][m][1][3];
                    s += ((o0[0] * o0[0] + o0[1] * o0[1]) + (o0[2] * o0[2] + o0[3] * o0[3])) + ((o1[0] * o1[0] + o1[1] * o1[1]) + (o1[2] * o1[2] + o1[3] * o1[3]));
                    u32x4 w; w.x = cvt_pk_bf16(o0[0], o0[1]); w.y = cvt_pk_bf16(o0[2], o0[3]); w.z = cvt_pk_bf16(o1[0], o1[1]); w.w = cvt_pk_bf16(o1[2], o1[3]);
                    *(u32x4*)(hb + off + bj * HALF) = w; }
                s += __shfl_xor(s, 16); s += __shfl_xor(s, 32);
                if (fq == 0) atomicAdd(ssq + r, s); }
    }
};
struct OneUnit {
    Unit u;
    __device__ __forceinline__ bool next(int i, Unit& o) const { if (i) return false; o = u; return true; }
    __device__ __forceinline__ void a_ready(const Unit&) const {}
    __device__ __forceinline__ void done(const Unit&) const {}
};
struct EpiDft1 {
    static constexpr bool PERM = true, AFTER_DRAIN = true;
    bf16_t* Tp; PG8_LAS unsigned char* lds;
    __device__ __forceinline__ void operator()(const f32x4 (&acc)[2][2][4][2], const Unit& u, int wr, int wc, int, int) const {
        int l_ = (int)lane_id_fresh(); asm volatile("" : "+v"(l_));
        const int fr = l_ & 15, fq = l_ >> 4;
        const int s1p = fr, kg = fq, part = kg >> 1, s1b = 8 * (kg & 1);
        bf16x8 bre, bim;
#pragma unroll
        for (int j = 0; j < 8; ++j) { const float ang = (float)(((s1b + j) * s1p) & 15) * (1.0f / 16.0f); const float c = __builtin_amdgcn_cosf(ang), sn = __builtin_amdgcn_sinf(ang);
            const float vre = part == 0 ? c : -sn, vim = part == 0 ? -sn : -c;
            bre[j] = (short)(cvt_pk_bf16(vre, 0.f) & 0xffffu); bim[j] = (short)(cvt_pk_bf16(vim, 0.f) & 0xffffu); }
        const int q = u.pn & 15, b = u.pn >> 4;
        float tc[4], ts[4];
#pragma unroll
        for (int i = 0; i < 4; ++i) { const float ang = (float)((q * 16 + 4 * kg + i) * s1p) * (1.0f / 4096.0f); tc[i] = __builtin_amdgcn_cosf(ang); ts[i] = __builtin_amdgcn_sinf(ang); }
        asm volatile("s_waitcnt vmcnt(0)" ::: "memory"); __builtin_amdgcn_s_barrier();
#pragma unroll
        for (int ai = 0; ai < 2; ++ai)
#pragma unroll
            for (int m = 0; m < 4; ++m) { const int R = ai * HALF + wr * 64 + m * 16 + fr;
#pragma unroll
                for (int bj = 0; bj < 2; ++bj) { const int c = 16 * bj + 4 * wc + fq, slot = ((c >> 1) + 16 * (c & 1)) ^ fr;
                    const f32x4 v0 = acc[ai][bj][m][0], v1 = acc[ai][bj][m][1];
                    u32x4 w; w.x = cvt_pk_bf16(v0[0], v0[1]); w.y = cvt_pk_bf16(v0[2], v0[3]); w.z = cvt_pk_bf16(v1[0], v1[1]); w.w = cvt_pk_bf16(v1[2], v1[3]);
                    *(PG8_LAS u32x4*)(lds + R * 512 + slot * 16) = w; } }
        asm volatile("s_waitcnt lgkmcnt(0)" ::: "memory"); __builtin_amdgcn_s_barrier();
        const int nl0 = (wr * 4 + wc) * 16;
        bf16_t* tout = Tp + (((size_t)b * 1024 + u.pm * 128 + nl0) * 16 + s1p) * 512 + q * 32 + 8 * kg;
        const int rdslot = s1p + 16 * (kg & 1);
#pragma unroll 4
        for (int j = 0; j < 16; ++j) { const int R = 2 * (nl0 + j) + part;
            const bf16x8 av = *(const PG8_LAS bf16x8*)(lds + R * 512 + ((rdslot ^ (R & 15)) * 16));
            const f32x4 z4 = {0.f, 0.f, 0.f, 0.f};
            const f32x4 cre = __builtin_amdgcn_mfma_f32_16x16x32_bf16(av, bre, z4, 0, 0, 0), cim = __builtin_amdgcn_mfma_f32_16x16x32_bf16(av, bim, z4, 0, 0, 0);
            u32x4 w;
            w.x = cvt_pk_bf16(cre[0] * tc[0] + cim[0] * ts[0], cim[0] * tc[0] - cre[0] * ts[0]); w.y = cvt_pk_bf16(cre[1] * tc[1] + cim[1] * ts[1], cim[1] * tc[1] - cre[1] * ts[1]);
            w.z = cvt_pk_bf16(cre[2] * tc[2] + cim[2] * ts[2], cim[2] * tc[2] - cre[2] * ts[2]); w.w = cvt_pk_bf16(cre[3] * tc[3] + cim[3] * ts[3], cim[3] * tc[3] - cre[3] * ts[3]);
            *(u32x4*)(tout + (size_t)j * 16 * 512) = w; }
    }
};
struct EpiResOut {
    static constexpr bool PERM = true, AFTER_DRAIN = false;
    const bf16_t* hb; unsigned long long* sx; float* out; const float* gf; unsigned* tmo; int ldc; unsigned need;
    __device__ __forceinline__ void operator()(f32x4 (&acc)[2][2][4][2], const Unit& u, int wr, int wc, int fr, int fq) const {
        int l_ = (int)lane_id_fresh(); asm volatile("" : "+v"(l_)); fr = l_ & 15; fq = l_ >> 4;
        const int row0 = u.pm * BM + wr * 64 + fr, col0 = u.pn * BM + wc * 32 + 8 * fq;
        {
            u32x4 bv[2][4][2];
#pragma unroll
            for (int ai = 0; ai < 2; ++ai)
#pragma unroll
                for (int m = 0; m < 4; ++m) { const size_t off = (size_t)(row0 + ai * HALF + m * 16) * ldc + col0;
#pragma unroll
                    for (int bj = 0; bj < 2; ++bj) bv[ai][m][bj] = __builtin_nontemporal_load((const u32x4*)(hb + off + bj * HALF)); }
#pragma unroll
            for (int ai = 0; ai < 2; ++ai)
#pragma unroll
                for (int m = 0; m < 4; ++m) { const int r = row0 + ai * HALF + m * 16; float s = 0.f;
#pragma unroll
                    for (int bj = 0; bj < 2; ++bj) { const u32x4 b = bv[ai][m][bj];
                        f32x4 o0 = acc[ai][bj][m][0], o1 = acc[ai][bj][m][1];
                        o0[0] += __builtin_bit_cast(float, b.x << 16); o0[1] += __builtin_bit_cast(float, b.x & 0xffff0000u);
                        o0[2] += __builtin_bit_cast(float, b.y << 16); o0[3] += __builtin_bit_cast(float, b.y & 0xffff0000u);
                        o1[0] += __builtin_bit_cast(float, b.z << 16); o1[1] += __builtin_bit_cast(float, b.z & 0xffff0000u);
                        o1[2] += __builtin_bit_cast(float, b.w << 16); o1[3] += __builtin_bit_cast(float, b.w & 0xffff0000u);
                        s += ((o0[0] * o0[0] + o0[1] * o0[1]) + (o0[2] * o0[2] + o0[3] * o0[3])) + ((o1[0] * o1[0] + o1[1] * o1[1]) + (o1[2] * o1[2] + o1[3] * o1[3]));
                        acc[ai][bj][m][0] = o0; acc[ai][bj][m][1] = o1; }
                    s += __shfl_xor(s, 16); s += __shfl_xor(s, 32);
                    if (fq == 0) (void)__hip_atomic_fetch_add(sx + r, (1ull << 40) | (unsigned long long)(s * 16384.0f + 0.5f), __ATOMIC_RELAXED, __HIP_MEMORY_SCOPE_AGENT); }
        }
        f32x4 gv[2][2];
#pragma unroll
        for (int bj = 0; bj < 2; ++bj)
#pragma unroll
            for (int n = 0; n < 2; ++n) gv[bj][n] = *(const f32x4*)(gf + col0 + bj * HALF + 4 * n);
        float iv[2][4];
        { unsigned sp = 0u;
          { const unsigned long long* w0 = sx + (u.pm * BM + wr * 64);
            while ((unsigned)(__hip_atomic_load(w0, __ATOMIC_RELAXED, __HIP_MEMORY_SCOPE_AGENT) >> 40) < need) { __builtin_amdgcn_s_sleep(2);
                if ((++sp & 255u) == 0u) { if (__hip_atomic_load(tmo, __ATOMIC_RELAXED, __HIP_MEMORY_SCOPE_AGENT)) break; if (sp > (1u << 20)) { atomicAdd(tmo, 1u); break; } } } }
          for (;;) { bool ok = true;
#pragma unroll
              for (int ai = 0; ai < 2; ++ai)
#pragma unroll
                  for (int m = 0; m < 4; ++m) { const unsigned long long w = __hip_atomic_load(sx + row0 + ai * HALF + m * 16, __ATOMIC_RELAXED, __HIP_MEMORY_SCOPE_AGENT);
                      ok = ok && ((unsigned)(w >> 40) >= need); iv[ai][m] = (float)(unsigned)w * (1.0f / 16384.0f); }
              if (__all(ok)) break;
              __builtin_amdgcn_s_sleep(1);
              if ((++sp & 255u) == 0u) { if (__hip_atomic_load(tmo, __ATOMIC_RELAXED, __HIP_MEMORY_SCOPE_AGENT)) break; if (sp > (1u << 20)) { atomicAdd(tmo, 1u); break; } } } }
#pragma unroll
        for (int ai = 0; ai < 2; ++ai)
#pragma unroll
            for (int m = 0; m < 4; ++m) { const float inv = __builtin_amdgcn_rsqf(iv[ai][m] * (1.0f / DM) + EPS); float* rowp = out + (size_t)(row0 + ai * HALF + m * 16) * ldc + col0;
#pragma unroll
                for (int bj = 0; bj < 2; ++bj) { *(f32x4*)(rowp + bj * HALF) = acc[ai][bj][m][0] * inv * gv[bj][0]; *(f32x4*)(rowp + bj * HALF + 4) = acc[ai][bj][m][1] * inv * gv[bj][1]; } }
    }
};
struct EpiY {
    static constexpr bool PERM = true, AFTER_DRAIN = false;
    bf16_t* O; int ldc;
    __device__ __forceinline__ void operator()(const f32x4 (&acc)[2][2][4][2], const Unit& u, int wr, int wc, int fr, int fq) const {
        { int l_ = (int)lane_id_fresh(); asm volatile("" : "+v"(l_)); fr = l_ & 15; fq = l_ >> 4; }
        const int rl0 = wr * 64 + fr, col0 = u.pn * BM + wc * 32 + 8 * fq; const int tok0 = (u.pm >> 4) * 4096 + (u.pm & 15);
#pragma unroll
        for (int ai = 0; ai < 2; ++ai)
#pragma unroll
            for (int m = 0; m < 4; ++m) { const int rl = rl0 + ai * HALF + m * 16; bf16_t* rowp = O + (size_t)(tok0 + 16 * rl) * ldc + col0;
#pragma unroll
                for (int bj = 0; bj < 2; ++bj) { const f32x4 v0 = acc[ai][bj][m][0], v1 = acc[ai][bj][m][1];
                    u32x4 w; w.x = cvt_pk_bf16(v0[0], v0[1]); w.y = cvt_pk_bf16(v0[2], v0[3]); w.z = cvt_pk_bf16(v1[0], v1[1]); w.w = cvt_pk_bf16(v1[2], v1[3]);
                    *(u32x4*)(rowp + bj * HALF) = w; } }
    }
};

typedef int v4i_t __attribute__((ext_vector_type(4)));
template <class Epi, class Sched, class Addr, bool ALIGN_EPI, int TSW = 0>
__device__ __forceinline__ void gemm_phase(PG8_LAS unsigned char* lds, const int K, const Addr g, const Sched& S, const Epi& E, const int wid  ) {
    int lane_ = (int)lane_id_fresh(); asm volatile("" : "+v"(lane_));
    const int lane = lane_, tid = wid * 64 + lane, wr = wid >> 2, wc = wid & 3, fr = lane & 15, fq = lane >> 4;
    const int nt = K / BK;
    unsigned voffA[2], voffB[2];
#pragma unroll
    for (int i = 0; i < 2; ++i) { int R, C; stage_rc(tid * 16 + i * 8192, R, C); const int Rb = Epi::PERM ? ((R & ~31) + perm32(R & 31)) : R;
        voffA[i] = g.voffA(R, C); voffB[i] = g.voffB(Rb, C); }
    const size_t kstep = (size_t)(BK * 2);
    const size_t hstepA = g.hA(), hstepB = g.hB();
    const unsigned ldsw = (unsigned)wid * 1024u;
    const int aoff = lds_byte(wr * 64 + fr, fq * 8), boff = lds_byte(wc * 32 + fr, fq * 8);
#define PG8_SA(b, h) (((b) * 2 + (h)) * HTB)
#define PG8_SB(b, h) ((4 + (b) * 2 + (h)) * HTB)
#define PG8_STAGE(bufoff, gbase, voff) do { _Pragma("unroll") for (int _i = 0; _i < 2; ++_i) { const unsigned _vo = (voff)[_i]; \
        __builtin_amdgcn_global_load_lds((const PG8_GAS unsigned*)((const PG8_GAS char*)(gbase) + _vo), (PG8_LAS unsigned*)(lds + (bufoff) + ldsw + _i * 8192), 16, 0, 0); } } while (0)
#define PG8_LDA(dst, b, h) do { _Pragma("unroll") for (int m = 0; m < 4; ++m) _Pragma("unroll") for (int k = 0; k < 2; ++k) dst[m][k] = *(const PG8_LAS bf16x8*)(lds + PG8_SA(b, h) + aoff + m * 2048 + k * 1024); } while (0)
#define PG8_LDB(dst, b, h) do { _Pragma("unroll") for (int n = 0; n < 2; ++n) _Pragma("unroll") for (int k = 0; k < 2; ++k) dst[n][k] = *(const PG8_LAS bf16x8*)(lds + PG8_SB(b, h) + boff + n * 2048 + k * 1024); } while (0)
#define PG8_MMA(ai, bj, At, Bt) do { __builtin_amdgcn_s_setprio(1); _Pragma("unroll") for (int m = 0; m < 4; ++m) _Pragma("unroll") for (int n = 0; n < 2; ++n) _Pragma("unroll") for (int k = 0; k < 2; ++k) \
        acc[ai][bj][m][n] = __builtin_amdgcn_mfma_f32_16x16x32_bf16(Bt[n][k], At[m][k], acc[ai][bj][m][n], 0, 0, 0); __builtin_amdgcn_s_setprio(0); } while (0)
#define PG8_CAT(x, y) __builtin_shufflevector(__builtin_bit_cast(v4i_t, x), __builtin_bit_cast(v4i_t, y), 0, 1, 2, 3, 4, 5, 6, 7)
#define PG8_MMA8(ai, bj, At, Bt) do { __builtin_amdgcn_s_setprio(1); _Pragma("unroll") for (int m = 0; m < 4; ++m) _Pragma("unroll") for (int n = 0; n < 2; ++n) \
        acc[ai][bj][m][n] = __builtin_amdgcn_mfma_scale_f32_16x16x128_f8f6f4(PG8_CAT(Bt[n][0], Bt[n][1]), PG8_CAT(At[m][0], At[m][1]), acc[ai][bj][m][n], 0, 0, 0, 0, 0, 0); __builtin_amdgcn_s_setprio(0); } while (0)
#define PG8_WAIT_V(n) asm volatile("s_waitcnt vmcnt(" #n ")" ::: "memory")
#define PG8_WAIT_L(n) asm volatile("s_waitcnt lgkmcnt(" #n ")" ::: "memory")
#define PG8_BAR __builtin_amdgcn_s_barrier()
#define PG8_SCHED __builtin_amdgcn_sched_barrier(0)
    Unit cur, nxt; int ui = 0;
    if (!S.next(0, cur)) return;
    f32x4 acc[2][2][4][2];
#pragma unroll
    for (int a = 0; a < 2; ++a)
#pragma unroll
        for (int b = 0; b < 2; ++b)
#pragma unroll
            for (int m = 0; m < 4; ++m)
#pragma unroll
                for (int n = 0; n < 2; ++n) acc[a][b][m][n] = (f32x4){0.f, 0.f, 0.f, 0.f};
    bf16x8 At[4][2], B0[2][2], B1[2][2];
    const char* cA = g.a(cur); const char* cB = g.b(cur);
    S.a_ready(cur);
    PG8_STAGE(PG8_SB(0, 0), cB, voffB); PG8_STAGE(PG8_SB(0, 1), cB + hstepB, voffB); PG8_STAGE(PG8_SA(0, 0), cA, voffA); PG8_STAGE(PG8_SA(0, 1), cA + hstepA, voffA);
    if (wr == 1) PG8_BAR;
    PG8_WAIT_V(2); PG8_BAR;
    PG8_STAGE(PG8_SB(1, 0), cB + kstep, voffB); PG8_STAGE(PG8_SA(1, 0), cA + kstep, voffA); PG8_STAGE(PG8_SB(1, 1), cB + hstepB + kstep, voffB);
    PG8_WAIT_V(6); PG8_BAR;
    for (;;) {
        const bool has_next = S.next(ui + 1, nxt);
        const char* nA = has_next ? g.a(nxt) : cA;
        const char* nB = has_next ? g.b(nxt) : cB;
#define PG8_BODY(MM) \
            asm volatile("" : "+v"(voffA[0]), "+v"(voffA[1]), "+v"(voffB[0]), "+v"(voffB[1]));   \
            const bool last = (t == nt - 2); \
            const char* a1 = cA + (size_t)(t + 1) * kstep; \
            const char* a2 = last ? nA : cA + (size_t)(t + 2) * kstep; const char* b2 = last ? nB : cB + (size_t)(t + 2) * kstep; \
            const char* a3 = a2 + kstep; const char* b3 = b2 + kstep; \
            const char* a1h = a1 + hstepA; const char* a2h = a2 + hstepA; const char* b2h = b2 + hstepB; const char* b3h = b3 + hstepB; \
            asm volatile("" : "+s"(a1h), "+s"(a2), "+s"(a2h), "+s"(a3), "+s"(b2), "+s"(b2h), "+s"(b3), "+s"(b3h));   \
            if (last && has_next) S.a_ready(nxt); \
            PG8_LDB(B0, 0, 0); PG8_LDB(B1, 0, 1); PG8_SCHED; PG8_LDA(At, 0, 0); PG8_STAGE(PG8_SA(1, 1), a1h, voffA); \
            PG8_WAIT_V(8); PG8_WAIT_L(0); PG8_BAR; MM(0, 0, At, B0); MM(0, 1, At, B1); PG8_BAR; PG8_SCHED; \
            PG8_LDA(At, 0, 1); PG8_STAGE(PG8_SB(0, 0), b2, voffB); PG8_STAGE(PG8_SB(0, 1), b2h, voffB); PG8_STAGE(PG8_SA(0, 0), a2, voffA); \
            PG8_WAIT_V(8); PG8_WAIT_L(0); PG8_BAR; MM(1, 0, At, B0); MM(1, 1, At, B1); PG8_BAR; PG8_SCHED; \
            PG8_LDB(B0, 1, 0); PG8_LDB(B1, 1, 1); PG8_SCHED; PG8_LDA(At, 1, 0); PG8_STAGE(PG8_SA(0, 1), a2h, voffA); \
            PG8_WAIT_V(8); PG8_WAIT_L(0); PG8_BAR; MM(0, 0, At, B0); MM(0, 1, At, B1); PG8_BAR; PG8_SCHED; \
            PG8_LDA(At, 1, 1); PG8_STAGE(PG8_SB(1, 0), b3, voffB); PG8_STAGE(PG8_SB(1, 1), b3h, voffB); PG8_STAGE(PG8_SA(1, 0), a3, voffA); \
            PG8_WAIT_V(8); PG8_WAIT_L(0); PG8_BAR; MM(1, 0, At, B0); MM(1, 1, At, B1); PG8_BAR; PG8_SCHED;
        { const int tmid = (TSW > 0 && TSW < nt) ? TSW : nt;
          _Pragma("unroll 1") for (int t = 0; t < tmid; t += 2) { PG8_BODY(PG8_MMA) }
          if constexpr (TSW > 0) { _Pragma("unroll 1") for (int t = tmid; t < nt; t += 2) { PG8_BODY(PG8_MMA8) } } }
#undef PG8_BODY
        if constexpr (ALIGN_EPI) { if (wr == 0) PG8_BAR; }
        E(acc, cur, wr, wc, 0, 0); S.done(cur);
        if (!has_next) break;
#pragma unroll
        for (int a = 0; a < 2; ++a)
#pragma unroll
            for (int b = 0; b < 2; ++b)
#pragma unroll
                for (int m = 0; m < 4; ++m)
#pragma unroll
                    for (int n = 0; n < 2; ++n) acc[a][b][m][n] = (f32x4){0.f, 0.f, 0.f, 0.f};
        cur = nxt; cA = nA; cB = nB; ++ui;
        if constexpr (ALIGN_EPI) { if (wr == 1) PG8_BAR; }
    }
    if constexpr (!Epi::AFTER_DRAIN) PG8_WAIT_V(0);
    if constexpr (!ALIGN_EPI) { if (wr == 0) PG8_BAR; }
    PG8_BAR;
#undef PG8_SA
#undef PG8_SB
#undef PG8_STAGE
#undef PG8_LDA
#undef PG8_LDB
#undef PG8_MMA
#undef PG8_MMA8
#undef PG8_CAT
#undef PG8_WAIT_V
#undef PG8_WAIT_L
#undef PG8_BAR
#undef PG8_SCHED
}
}

typedef unsigned short bf16_t;
typedef short bf16x8 __attribute__((ext_vector_type(8)));
typedef float f32x4 __attribute__((ext_vector_type(4)));
typedef unsigned v4u __attribute__((ext_vector_type(4)));
#define GAS __attribute__((address_space(1)))
#define LAS __attribute__((address_space(3)))
using pg8::lane_id_fresh;
constexpr int NWAVES = 8;
constexpr int WGM_F = 16, WGM_Q = 8, WGM_O = 1, WGM_U = 4, WGM_D = 4;

constexpr size_t MiB = 1u << 20;
constexpr size_t WS_CTL = 0, CTL_ZERO_BYTES = 1 * MiB;
constexpr int CW_BAR = 4096;
constexpr int CW_EXCH = 16384;
constexpr size_t WS_SSQ1 = 256 * 1024;
constexpr size_t WS_SSQX = 512 * 1024;
constexpr size_t WS_SSQ2 = 384 * 1024;
constexpr size_t WS_INV0 = 1 * MiB;
constexpr size_t WS_TRIG2 = 3 * MiB;
constexpr size_t WS_ABT  = 2 * MiB;
constexpr size_t WS_WINT = 4 * MiB;
constexpr size_t WS_WO   = 28 * MiB;
constexpr size_t WS_WUP  = 36 * MiB;
constexpr size_t WS_WD   = 68 * MiB;
constexpr size_t WS_H1B  = 100 * MiB;
constexpr size_t WS_XB   = 164 * MiB;
constexpr size_t WS_Y    = 324 * MiB;
constexpr size_t WS_Q    = 228 * MiB;
constexpr size_t WS_ZT   = 388 * MiB;
constexpr size_t WS_A    = 324 * MiB;
constexpr size_t WS_END  = 452 * MiB;
static_assert(WS_SSQ2 + (size_t)T * 4 <= CTL_ZERO_BYTES, "ssq inside the memset region");

constexpr int RING_BYTES = 131072;
constexpr int LDSCTL_OFF = RING_BYTES, MISC_OFF = LDSCTL_OFF + 320;
constexpr int LDS_BYTES = 147456;

#define LDS_WAIT() asm volatile("s_waitcnt lgkmcnt(0)" ::: "memory")
__device__ __forceinline__ unsigned f2bf(float f) { unsigned u = __builtin_bit_cast(unsigned, f); return (u + 0x7fffu + ((u >> 16) & 1u)) >> 16; }
__device__ __forceinline__ unsigned pk2(float lo, float hi) { return pg8::cvt_pk_bf16(lo, hi); }
__device__ __forceinline__ float bf2f(unsigned v) { return __builtin_bit_cast(float, v << 16); }
__device__ __forceinline__ float wave_sum(float v) {
#pragma unroll
    for (int o = 1; o < 64; o <<= 1) v += __shfl_xor(v, o);
    return v;
}
__device__ __forceinline__ float wave_max(float v) {
#pragma unroll
    for (int o = 1; o < 64; o <<= 1) v = fmaxf(v, __shfl_xor(v, o));
    return v;
}

#define XB_TMO      128
#define XB_XCNT(j)  (256  + 64 * (j))
#define XB_XSUB(j)  (1280 + 64 * (j))
#define XB_XGEN(j)  (2304 + 64 * (j))
#define XB_TOP      3328
#define XB_TOPGEN   3392
#define XCD_BAR_WORDS 3456
#define XB_SPIN_CAP (1u << 20)
__device__ __forceinline__ unsigned xb_ld(unsigned* p)              { return __hip_atomic_load(p, __ATOMIC_RELAXED, __HIP_MEMORY_SCOPE_AGENT); }
__device__ __forceinline__ unsigned xb_add(unsigned* p, unsigned v) { return __hip_atomic_fetch_add(p, v, __ATOMIC_RELAXED, __HIP_MEMORY_SCOPE_AGENT); }
__device__ __forceinline__ unsigned xb_xcc_id() { return (unsigned)__builtin_amdgcn_s_getreg((3 << 11) | 20) & 0xFu; }
#define XB_SPIN(cond, bar) do { unsigned _sp = 0; while (cond) { __builtin_amdgcn_s_sleep(1); \
    if ((++_sp & 255u) == 0u) { if (xb_ld(&(bar)[XB_TMO])) break; if (_sp > XB_SPIN_CAP) { atomicAdd(&(bar)[XB_TMO], 1u); break; } } } } while (0)
struct XcdBarrier { unsigned* bar; unsigned x; volatile LAS unsigned* st; };
__device__ __forceinline__ XcdBarrier xcd_barrier_post(unsigned* bar, volatile LAS unsigned* st) {
    XcdBarrier b; b.bar = bar; b.x = xb_xcc_id(); b.st = st;
    if (threadIdx.x == 0) (void)xb_add(&bar[XB_XCNT(b.x)], 1u);
    return b;
}
__device__ __forceinline__ void xcd_barrier_complete(unsigned* bar, unsigned x, unsigned& nloc, unsigned& nx) {
    const unsigned G = gridDim.x * gridDim.y * gridDim.z;
    unsigned sum, cnt, mine, sp = 0u;
    for (;;) {
        sum = 0u; cnt = 0u; mine = 0u;
#pragma unroll
        for (unsigned j = 0; j < 16; ++j) { const unsigned c = xb_ld(&bar[XB_XCNT(j)]); sum += c; cnt += (c > 0u) ? 1u : 0u; mine = (j == x) ? c : mine; }
        if (sum == G) break;
        __builtin_amdgcn_s_sleep(1);
        if ((++sp & 255u) == 0u) { if (xb_ld(&bar[XB_TMO])) break; if (sp > XB_SPIN_CAP) { atomicAdd(&bar[XB_TMO], 1u); break; } }
    }
    nloc = mine > 0u ? mine : 1u; nx = cnt > 0u ? cnt : 1u;
}
__device__ __forceinline__ void xcd_barrier(const XcdBarrier& b, const int wave) {
    asm volatile("s_waitcnt vmcnt(0)" ::: "memory");
    __syncthreads();
    if (wave == 0 && lane_id_fresh() == 0u) {
        unsigned* bar = b.bar;
        __builtin_amdgcn_s_waitcnt(0);
        unsigned nloc = b.st[0], nx = b.st[1];
        if (nloc == 0u) { xcd_barrier_complete(bar, b.x, nloc, nx); b.st[0] = nloc; b.st[1] = nx; }
        const unsigned old = xb_add(&bar[XB_XSUB(b.x)], 1u);
        const unsigned gen = old / nloc;
        if (old + 1u == (gen + 1u) * nloc) {
            __builtin_amdgcn_fence(__ATOMIC_RELEASE, "agent");
            asm volatile("s_waitcnt vmcnt(0)" ::: "memory");
            const unsigned og = xb_add(&bar[XB_TOP], 1u);
            const unsigned tg = og / nx;
            if (og + 1u == (tg + 1u) * nx) xb_add(&bar[XB_TOPGEN], 1u);
            else XB_SPIN(xb_ld(&bar[XB_TOPGEN]) == tg, bar);
            __builtin_amdgcn_fence(__ATOMIC_ACQUIRE, "agent");
            xb_add(&bar[XB_XGEN(b.x)], 1u);
            asm volatile("s_waitcnt vmcnt(0)" ::: "memory");
        } else {
            XB_SPIN(xb_ld(&bar[XB_XGEN(b.x)]) == gen, bar);
            __builtin_amdgcn_fence(__ATOMIC_ACQUIRE, "agent");
            asm volatile("s_waitcnt vmcnt(0)" ::: "memory");
        }
    }
    __syncthreads();
}

__device__ __forceinline__ void p0_transpose_item(const float* W, int ldw, int col_off, int K, int N, const float* rs, bf16_t* WT, LAS float* scr, int item, int lane) {
    const int nblk = N / 32, kb = item / nblk, nb = item % nblk, k0 = 64 * kb, n0 = 32 * nb;
    const int r8 = lane >> 3, c4 = (lane & 7) * 4;
    f32x4 v[8]; float sc[8];
#pragma unroll
    for (int i = 0; i < 8; ++i) { const int kk = 8 * i + r8; v[i] = __builtin_nontemporal_load((const GAS f32x4*)(W + (size_t)(k0 + kk) * ldw + col_off + n0 + c4)); sc[i] = rs ? rs[k0 + kk] : 1.0f; }
#pragma unroll
    for (int i = 0; i < 8; ++i) { LAS float* d = scr + (8 * i + r8) * 33 + c4; d[0] = v[i].x * sc[i]; d[1] = v[i].y * sc[i]; d[2] = v[i].z * sc[i]; d[3] = v[i].w * sc[i]; }
    LDS_WAIT();
    const int c = lane & 7;
#pragma unroll
    for (int j = 0; j < 4; ++j) { const int n = (lane >> 3) + 8 * j; const LAS float* s = scr + (8 * c) * 33 + n;
        v4u o; o.x = pk2(s[0 * 33], s[1 * 33]); o.y = pk2(s[2 * 33], s[3 * 33]); o.z = pk2(s[4 * 33], s[5 * 33]); o.w = pk2(s[6 * 33], s[7 * 33]);
        *(GAS v4u*)(WT + (size_t)(n0 + n) * K + k0 + 8 * c) = o; }
    LDS_WAIT();
}

__device__ __forceinline__ void p0_transpose_item_wo(const float* W, bf16_t* WT, LAS float* scr, int item, int lane) {
    const int kb = item >> 6, nb = item & 63, k0 = 64 * kb, n0 = 32 * nb;
    const int r8 = lane >> 3, c4 = (lane & 7) * 4;
    f32x4 v[8];
#pragma unroll
    for (int i = 0; i < 8; ++i) { const int kk = 8 * i + r8; v[i] = __builtin_nontemporal_load((const GAS f32x4*)(W + (size_t)(k0 + kk) * 2048 + n0 + c4)); }
#pragma unroll
    for (int i = 0; i < 8; ++i) { LAS float* d = scr + (8 * i + r8) * 33 + c4; d[0] = v[i].x * 32.f; d[1] = v[i].y * 32.f; d[2] = v[i].z * 32.f; d[3] = v[i].w * 32.f; }
    LDS_WAIT();
    const int c = lane & 7;
#pragma unroll
    for (int j = 0; j < 4; ++j) { const int n = (lane >> 3) + 8 * j; const LAS float* s = scr + (8 * c) * 33 + n;
        GAS unsigned char* row = (GAS unsigned char*)WT + (size_t)(n0 + n) * 3072;
        if (k0 < 1024) { v4u o; o.x = pk2(s[0 * 33], s[1 * 33]); o.y = pk2(s[2 * 33], s[3 * 33]); o.z = pk2(s[4 * 33], s[5 * 33]); o.w = pk2(s[6 * 33], s[7 * 33]);
            *(GAS v4u*)(row + (k0 + 8 * c) * 2) = o; }
        else { pg8::u32x2 o; o.x = pg8::pk_fp8x4((f32x4){s[0 * 33], s[1 * 33], s[2 * 33], s[3 * 33]}); o.y = pg8::pk_fp8x4((f32x4){s[4 * 33], s[5 * 33], s[6 * 33], s[7 * 33]});
            *(GAS pg8::u32x2*)(row + 2048 + (k0 - 1024) + 8 * c) = o; } }
    LDS_WAIT();
}

typedef float f32x16 __attribute__((ext_vector_type(16)));
typedef short s16x4 __attribute__((ext_vector_type(4)));
typedef unsigned u32x2 __attribute__((ext_vector_type(2)));
typedef float f32x2 __attribute__((ext_vector_type(2)));
__device__ __forceinline__ unsigned cvtpk(float lo, float hi) { unsigned r; asm volatile("v_cvt_pk_bf16_f32 %0, %1, %2" : "=v"(r) : "v"(lo), "v"(hi)); return r; }
#define SBAR() __builtin_amdgcn_sched_barrier(0)
constexpr float AT_THR = 8.0f;
constexpr int at_v_rd_off(int d0, int ks, int half) { return d0 * 512 + ks * 4096 + half * 2048; }
template <int OFF> __device__ __forceinline__ s16x4 tr_read(unsigned vb) {
    s16x4 r; asm volatile("ds_read_b64_tr_b16 %0, %1 offset:%2" : "=&v"(r) : "v"(vb), "i"(OFF) : "memory"); return r;
}
__device__ __forceinline__ int clampi(int v, int lo, int hi) { return v < lo ? lo : (v > hi ? hi : v); }
__device__ __forceinline__ void at_dma_k(LAS unsigned char* kdst, const bf16_t* kbase, int tq0, int dil, int tile, int lane_) {
    int lane = lane_; asm volatile("" : "+v"(lane));
    const int r0 = lane >> 3; const unsigned c0 = (unsigned)(((lane & 7) ^ r0) << 4);
    const int t0 = tq0 + dil * (32 * tile + r0 - 64), d8 = 8 * dil;
#pragma unroll
    for (int n = 0; n < 4; ++n) { int tkn = t0 + n * d8; tkn = tkn < 0 ? 0 : (tkn > SEQ - 1 ? SEQ - 1 : tkn);
        const unsigned off = ((unsigned)tkn << 7) + c0;
        __builtin_amdgcn_global_load_lds((const unsigned*)((const GAS char*)kbase + off), (LAS unsigned*)(kdst + n * 1024), 16, 0, 0); }
}
__device__ __forceinline__ long bf16x8_to_fp8(const bf16x8 v) {
    const v4u w = __builtin_bit_cast(v4u, v);
    int lo = __builtin_amdgcn_cvt_pk_fp8_f32(__builtin_bit_cast(float, w.x << 16), __builtin_bit_cast(float, w.x & 0xffff0000u), 0, false);
    lo = __builtin_amdgcn_cvt_pk_fp8_f32(__builtin_bit_cast(float, w.y << 16), __builtin_bit_cast(float, w.y & 0xffff0000u), lo, true);
    int hi = __builtin_amdgcn_cvt_pk_fp8_f32(__builtin_bit_cast(float, w.z << 16), __builtin_bit_cast(float, w.z & 0xffff0000u), 0, false);
    hi = __builtin_amdgcn_cvt_pk_fp8_f32(__builtin_bit_cast(float, w.w << 16), __builtin_bit_cast(float, w.w & 0xffff0000u), hi, true);
    return (long)(((unsigned long long)(unsigned)hi << 32) | (unsigned long long)(unsigned)lo);
}
__device__ __forceinline__ void at_dma_v(LAS unsigned char* vdst, const bf16_t* vbase, int tq0, int dil, int tile, int lane_) { at_dma_k(vdst, vbase, tq0, dil, tile, lane_); }
template <int OFF> __device__ __forceinline__ long tr8_read(unsigned vb) {
    long r; asm volatile("ds_read_b64_tr_b8 %0, %1 offset:%2" : "=&v"(r) : "v"(vb), "i"(OFF) : "memory"); return r;
}
constexpr int TRB8_MAP = 0;
__device__ __forceinline__ void at_load_q(bf16x8 (&qr)[8], const bf16_t* qb, int tq0, int dil, int lane) {
    const bf16_t* qrow = qb + (size_t)(tq0 + dil * (lane & 31)) * 128 + (lane >> 5) * 8;
#pragma unroll
    for (int s = 0; s < 8; ++s) qr[s] = *(const GAS bf16x8*)(qrow + 16 * s);
}
__device__ __forceinline__ void at_unit_prologue(LAS unsigned char* wl, bf16x8 (&qr)[8], const bf16_t* qb, const bf16_t* kb, const bf16_t* vb, int tq0, int dil, int lane) {
    at_dma_k(wl, kb, tq0, dil, 0, lane); at_dma_v(wl + 8192, vb, tq0, dil, 0, lane); at_load_q(qr, qb, tq0, dil, lane);
}
__device__ __forceinline__ void attn_unit(const bool FINAL, const bool HN, LAS unsigned char* wl, const bf16_t* qb, const bf16_t* kb, const bf16_t* vb, int tq0, int dil, float sl, bf16x8 (&qr)[8], const bf16_t* nqb, const bf16_t* nkb, const bf16_t* nvb, int ntq0, int ndil,
                                          bf16_t* part, float* ml, const bf16_t* part0, const bf16_t* part1, const float* ml0, const float* ml1, bf16_t* yout, int lane) {
    const int r32 = lane & 31, hi = lane >> 5;
    LAS unsigned char* kbuf = wl; LAS unsigned char* vbuf = wl + 8192;
    const int jlo = 64 - tq0 / dil, jhi = 64 + (SEQ - 1 - tq0) / dil;
    const float lo_i = (float)max(-64, jlo - 64 - r32), hi_i = (float)min(64, jhi - 64 - r32);
    const bool interior = (jlo <= 0) && (jhi >= 159);
    float m_run = -1e30f, l_run = 0.f;
    f32x16 oT[4];
#pragma unroll
    for (int d0 = 0; d0 < 4; ++d0)
#pragma unroll
        for (int r = 0; r < 16; ++r) oT[d0][r] = 0.f;
    asm volatile("s_waitcnt vmcnt(0)" ::: "memory");
#pragma unroll
    for (int s = 0; s < 8; ++s) asm volatile("" : "+v"(qr[s]));
    long q8[8];
#pragma unroll
    for (int s = 0; s < 8; ++s) q8[s] = bf16x8_to_fp8(qr[s]);
    f32x2 st1 = {0.f, 0.f}, st2 = {0.f, 0.f};
    if (FINAL) { const size_t tqs = (size_t)(tq0 + dil * r32) * 2; st1 = *(const GAS f32x2*)(ml0 + tqs); st2 = *(const GAS f32x2*)(ml1 + tqs); }
    const int rr0 = lane >> 4, cs = lane & 15;
    const LAS unsigned char* krd = kbuf + r32 * 128 + hi * 8;
    const int kx = (r32 & 7) << 4;
#pragma unroll 1
    for (int n = 0; n < 5; ++n) {
        if (n > 0) asm volatile("s_waitcnt vmcnt(4)" ::: "memory");
        SBAR();
        long kf[8];
#pragma unroll
        for (int s = 0; s < 8; ++s) kf[s] = *(const LAS long*)(krd + ((16 * s) ^ kx));
        asm volatile("s_waitcnt lgkmcnt(0)" ::: "memory"); SBAR();
        unsigned toff[4];
        if (n < 4 || HN) {
            const bf16_t* kbp = (n < 4) ? kb : nkb; const int ktq = (n < 4) ? tq0 : ntq0, kdl = (n < 4) ? dil : ndil, ktl = (n < 4) ? n + 1 : 0;
            int kl = lane; asm volatile("" : "+v"(kl));
            const int kr0 = kl >> 3; const unsigned kc0 = (unsigned)(((kl & 7) ^ kr0) << 4);
            const int kt0 = ktq + kdl * (32 * ktl + kr0 - 64), kd8 = 8 * kdl;
            if (interior && n < 4) {
#pragma unroll
                for (int i = 0; i < 4; ++i) toff[i] = ((unsigned)(kt0 + i * kd8) << 7) + kc0;
            } else {
#pragma unroll
                for (int i = 0; i < 4; ++i) { int tkn = kt0 + i * kd8; tkn = tkn < 0 ? 0 : (tkn > SEQ - 1 ? SEQ - 1 : tkn); toff[i] = ((unsigned)tkn << 7) + kc0; }
            }
#pragma unroll
            for (int i = 0; i < 4; ++i) __builtin_amdgcn_global_load_lds((const unsigned*)((const GAS char*)kbp + toff[i]), (LAS unsigned*)(kbuf + i * 1024), 16, 0, 0);
        }
        f32x16 p;
#pragma unroll
        for (int r = 0; r < 16; ++r) p[r] = 0.f;
#pragma unroll
        for (int s = 0; s < 8; ++s) p = __builtin_amdgcn_mfma_f32_32x32x16_fp8_fp8(kf[s], q8[s], p, 0, 0, 0);
        const float relb = (float)(32 * n + 4 * hi - 64 - r32) - 8.0f;
#define AT_CR(r) ((float)(((r) & 3) + 8 * ((r) >> 2) + 8))
        float tmax = -1e30f;
        if (interior && n == 2) {
#pragma unroll
            for (int r = 0; r < 16; ++r) { const float rel = relb + AT_CR(r); p[r] = p[r] - sl * fabsf(rel); tmax = fmaxf(tmax, p[r]); }
        } else if (interior) {
            const float ssl = (n < 2) ? sl : -sl;
            if (n == 0) {
#pragma unroll
                for (int r = 0; r < 16; ++r) { const float rel = relb + AT_CR(r); const float v = __builtin_fmaf(ssl, rel, p[r]); p[r] = (rel >= -64.f) ? v : -1e30f; tmax = fmaxf(tmax, p[r]); }
            } else if (n == 4) {
#pragma unroll
                for (int r = 0; r < 16; ++r) { const float rel = relb + AT_CR(r); const float v = __builtin_fmaf(ssl, rel, p[r]); p[r] = (rel <= 64.f) ? v : -1e30f; tmax = fmaxf(tmax, p[r]); }
            } else {
#pragma unroll
                for (int r = 0; r < 16; ++r) { const float rel = relb + AT_CR(r); p[r] = __builtin_fmaf(ssl, rel, p[r]); tmax = fmaxf(tmax, p[r]); }
            }
        } else {
#pragma unroll
            for (int r = 0; r < 16; ++r) { const float rel = relb + AT_CR(r); const bool ok = (rel >= lo_i) && (rel <= hi_i);
                p[r] = ok ? p[r] - sl * fabsf(rel) : -1e30f; tmax = fmaxf(tmax, p[r]); }
        }
#undef AT_CR
        { auto rr = __builtin_amdgcn_permlane32_swap(__float_as_uint(tmax), __float_as_uint(tmax), false, false); tmax = fmaxf(__uint_as_float(rr[0]), __uint_as_float(rr[1])); }
        float mn = m_run, alpha = 1.f;
        if (!__all(tmax - m_run <= AT_THR)) { mn = fmaxf(m_run, tmax); alpha = __builtin_amdgcn_exp2f(m_run - mn); m_run = mn;
            if (n > 0) {
#pragma unroll
            for (int d0 = 0; d0 < 4; ++d0)
#pragma unroll
                for (int r = 0; r < 16; ++r) oT[d0][r] *= alpha; } }
        float ps = 0.f;
#pragma unroll
        for (int r = 0; r < 16; ++r) { p[r] = __builtin_amdgcn_exp2f(p[r] - mn); ps += p[r]; }
        { auto rr = __builtin_amdgcn_permlane32_swap(__float_as_uint(ps), __float_as_uint(ps), false, false); ps = __uint_as_float(rr[0]) + __uint_as_float(rr[1]); }
        l_run = l_run * alpha + ps;
        long pa0, pa1;
#define AT_PK8(P, BASE, OUT) do { const unsigned a4 = pg8::pk_fp8x4((f32x4){P[BASE + 0], P[BASE + 1], P[BASE + 2], P[BASE + 3]}), b4 = pg8::pk_fp8x4((f32x4){P[BASE + 4], P[BASE + 5], P[BASE + 6], P[BASE + 7]}); \
        auto r0 = __builtin_amdgcn_permlane32_swap(a4, b4, false, false); OUT = (long)(((unsigned long long)r0[1] << 32) | (unsigned long long)r0[0]); } while (0)
        AT_PK8(p, 0, pa0); AT_PK8(p, 8, pa1);
#undef AT_PK8
        if (n < 4 || HN) asm volatile("s_waitcnt vmcnt(4)" ::: "memory");
        else asm volatile("s_waitcnt vmcnt(0)" ::: "memory");
        SBAR();
        {
            int vl_ = lane; asm volatile("" : "+v"(vl_));
            const int vg = vl_ & 15, vgrp = vl_ >> 4, vr = TRB8_MAP ? (vg & 7) : (vg >> 1), vc = TRB8_MAP ? (vg >> 3) : (vg & 1);
            const unsigned vb0 = (unsigned)(uintptr_t)vbuf + (unsigned)((8 * (vgrp >> 1) + vr) * 128 + 8 * vc);
            long vf[4][2];
#define AT_RD8(D0) do { const unsigned va_ = vb0 + (unsigned)((((2 * D0 + (vgrp & 1)) ^ vr) & 7) << 4); vf[D0][0] = tr8_read<0>(va_); vf[D0][1] = tr8_read<2048>(va_); } while (0)
            AT_RD8(0); AT_RD8(1); AT_RD8(2); AT_RD8(3);
#undef AT_RD8
            asm volatile("s_waitcnt lgkmcnt(0)" ::: "memory"); SBAR();
            if (n < 4) {
#pragma unroll
                for (int i = 0; i < 4; ++i) __builtin_amdgcn_global_load_lds((const unsigned*)((const GAS char*)vb + toff[i]), (LAS unsigned*)(vbuf + i * 1024), 16, 0, 0); }
#pragma unroll
            for (int d0 = 0; d0 < 4; ++d0) {
                oT[d0] = __builtin_amdgcn_mfma_f32_32x32x16_fp8_fp8(vf[d0][0], pa0, oT[d0], 0, 0, 0);
                oT[d0] = __builtin_amdgcn_mfma_f32_32x32x16_fp8_fp8(vf[d0][1], pa1, oT[d0], 0, 0, 0); }
        }
    }
    if (HN) at_load_q(qr, nqb, ntq0, ndil, lane);
    const int tq = tq0 + dil * r32;
    v4u a0[8], a1v[8];
    if (FINAL) {
#pragma unroll
        for (int i = 0; i < 8; ++i) { const int row = 4 * i + rr0, c = cs ^ (row & 15); const size_t off = (size_t)(tq0 + dil * row) * 128 + 8 * c;
            a0[i] = __builtin_nontemporal_load((const GAS v4u*)(part0 + off)); a1v[i] = __builtin_nontemporal_load((const GAS v4u*)(part1 + off)); } }
    float osc, c1 = 0.f, c2 = 0.f;
    if (!FINAL) { osc = 1.0f / l_run; if (hi == 0) *(GAS f32x2*)(ml + (size_t)tq * 2) = (f32x2){m_run, l_run}; }
    else {
        const f32x2 s1 = st1, s2 = st2;
        const float M = fmaxf(fmaxf(s1.x, s2.x), m_run);
        const float a1 = __builtin_amdgcn_exp2f(s1.x - M) * s1.y, a2 = __builtin_amdgcn_exp2f(s2.x - M) * s2.y, a3 = __builtin_amdgcn_exp2f(m_run - M);
        const float inv = 1.0f / (a1 + a2 + a3 * l_run);
        c1 = a1 * inv; c2 = a2 * inv; osc = a3 * inv;
    }
    {
        LAS unsigned char* wrow = vbuf + r32 * 256 + hi * 8; const int qx = r32 & 15;
#pragma unroll
        for (int d0 = 0; d0 < 4; ++d0)
#pragma unroll
            for (int g4 = 0; g4 < 4; ++g4) { u32x2 w; w.x = cvtpk(oT[d0][4 * g4] * osc, oT[d0][4 * g4 + 1] * osc); w.y = cvtpk(oT[d0][4 * g4 + 2] * osc, oT[d0][4 * g4 + 3] * osc);
                *(LAS u32x2*)(wrow + (((4 * d0 + g4) ^ qx) << 4)) = w; }
    }
    asm volatile("s_waitcnt lgkmcnt(0)" ::: "memory"); SBAR();
    if (!FINAL) {
#pragma unroll
        for (int i = 0; i < 8; ++i) a0[i] = *(const LAS v4u*)(vbuf + (4 * i + rr0) * 256 + cs * 16);
#pragma unroll
        for (int i = 0; i < 8; ++i) { const int row = 4 * i + rr0, c = cs ^ (row & 15);
            *(GAS v4u*)(part + (size_t)(tq0 + dil * row) * 128 + 8 * c) = a0[i]; }
    } else {
#pragma unroll
        for (int i = 0; i < 8; ++i) { const int row = 4 * i + rr0, c = cs ^ (row & 15);
            const float w1 = __shfl(c1, row), w2 = __shfl(c2, row);
            const v4u o = *(const LAS v4u*)(vbuf + row * 256 + cs * 16);
            float f8[8];
#define AT_MIX(F, J) do { f8[2 * J] = w1 * bf2f(a0[i].F & 0xffffu) + w2 * bf2f(a1v[i].F & 0xffffu) + bf2f(o.F & 0xffffu); \
                f8[2 * J + 1] = w1 * bf2f(a0[i].F >> 16) + w2 * bf2f(a1v[i].F >> 16) + bf2f(o.F >> 16); } while (0)
            AT_MIX(x, 0); AT_MIX(y, 1); AT_MIX(z, 2); AT_MIX(w, 3);
#undef AT_MIX
            u32x2 r8; r8.x = pg8::pk_fp8x4((f32x4){f8[0], f8[1], f8[2], f8[3]}); r8.y = pg8::pk_fp8x4((f32x4){f8[4], f8[5], f8[6], f8[7]});
            *(GAS u32x2*)((GAS unsigned char*)yout + (size_t)(tq0 + dil * row) * 3072 + 8 * c) = r8; }
    }
    asm volatile("s_waitcnt lgkmcnt(0)" ::: "memory"); SBAR();
    if (HN) at_dma_v(vbuf, nvb, ntq0, ndil, 0, lane);
}

struct Args { const float* in[9]; float* out; unsigned char* ws; };

__global__ void __launch_bounds__(NWAVES * 64, 2) mk_fwd(Args args) {
    extern __shared__ __attribute__((aligned(16))) unsigned char lds_raw[];
    LAS unsigned char* lds = (LAS unsigned char*)lds_raw;
    volatile LAS unsigned* MISC = (volatile LAS unsigned*)(lds + MISC_OFF);
    const int tid = threadIdx.x, lane = tid & 63, wave = __builtin_amdgcn_readfirstlane(tid >> 6);
    const int G = gridDim.x, gw = blockIdx.x * NWAVES + wave, NGW = G * NWAVES;
    unsigned char* ws = args.ws;
    const float* x = args.in[0]; const float* g_mix = args.in[1]; const float* w_in = args.in[2]; const float* w_f = args.in[3];
    const float* w_out = args.in[4]; const float* g_mlp = args.in[5]; const float* w_up = args.in[6]; const float* w_down = args.in[7]; const float* g_fin = args.in[8];
    float* out = args.out;
    float* ssq1 = (float*)(ws + WS_SSQ1); float* ssq2 = (float*)(ws + WS_SSQ2); float* inv0 = (float*)(ws + WS_INV0);
    bf16_t* abt = (bf16_t*)(ws + WS_ABT);
    bf16_t* wint = (bf16_t*)(ws + WS_WINT); bf16_t* wo = (bf16_t*)(ws + WS_WO); bf16_t* wup = (bf16_t*)(ws + WS_WUP); bf16_t* wd = (bf16_t*)(ws + WS_WD);
    bf16_t* h1b = (bf16_t*)(ws + WS_H1B); bf16_t* xb = (bf16_t*)(ws + WS_XB); bf16_t* y = (bf16_t*)(ws + WS_Y);
    bf16_t* qkv = (bf16_t*)(ws + WS_Q); bf16_t* zt = (bf16_t*)(ws + WS_ZT); bf16_t* trig2 = (bf16_t*)(ws + WS_TRIG2); bf16_t* abuf = (bf16_t*)(ws + WS_A);

    for (int u = tid; u < (LDS_BYTES - LDSCTL_OFF) / 4; u += NWAVES * 64) ((LAS unsigned*)(lds + LDSCTL_OFF))[u] = 0u;
    __syncthreads();
    XcdBarrier bar = xcd_barrier_post((unsigned*)(ws + WS_CTL) + CW_BAR, MISC + 8);

    {
        LAS float* scr = (LAS float*)(lds + wave * 16384);
        for (int m = gw; m < T; m += NGW) {
            const GAS f32x4* xr = (const GAS f32x4*)(x + (size_t)m * DM) + lane; f32x4 v[8]; float s = 0.f;
#pragma unroll
            for (int j = 0; j < 8; ++j) { v[j] = __builtin_nontemporal_load(&xr[64 * j]); s += (v[j].x * v[j].x + v[j].y * v[j].y) + (v[j].z * v[j].z + v[j].w * v[j].w); }
            s = wave_sum(s);
            if (lane == 0) { const float iv = 1.0f / sqrtf(s * (1.0f / DM) + EPS); inv0[m] = iv; }
            GAS unsigned long long* o8 = (GAS unsigned long long*)(xb + (size_t)m * DM) + lane;
#pragma unroll
            for (int j = 0; j < 8; ++j) o8[64 * j] = (unsigned long long)pk2(v[j].x, v[j].y) | ((unsigned long long)pk2(v[j].z, v[j].w) << 32);
        }
        {
            LAS unsigned* ctu = (LAS unsigned*)(scr + 2304); LAS unsigned* stu = (LAS unsigned*)(scr + 2560);
            for (int j = lane; j < 256; j += 64) { ctu[j] = f2bf(cospif((float)j / 128.0f)); stu[j] = f2bf(sinpif((float)j / 128.0f)); }
            LDS_WAIT();
            typedef float f32x4v __attribute__((ext_vector_type(4)));
            for (int it = gw; it < 4 * 16 * 16; it += NGW) {
                const int cb = it & 15, ebk = (it >> 4) & 15, g = it >> 8, i16 = lane & 15, kg = lane >> 4, c = cb * 16 + i16;
                const float* wcol = w_f + (size_t)g * 65536 + ebk * 16 + i16;
                f32x4v dc = {0.f, 0.f, 0.f, 0.f}, ds = {0.f, 0.f, 0.f, 0.f};
#pragma unroll 2
                for (int ks = 0; ks < 8; ++ks) { const int k0 = 32 * ks + 8 * kg;
                    float wv[8];
#pragma unroll
                    for (int j = 0; j < 8; ++j) wv[j] = wcol[(size_t)(k0 + j) * 256];
                    v4u bw, ac, as;
                    bw.x = pg8::cvt_pk_bf16(wv[0], wv[1]); bw.y = pg8::cvt_pk_bf16(wv[2], wv[3]); bw.z = pg8::cvt_pk_bf16(wv[4], wv[5]); bw.w = pg8::cvt_pk_bf16(wv[6], wv[7]);
#define ABT_PH(J) ((c * (k0 + (J))) & 255)
                    ac.x = ctu[ABT_PH(0)] | (ctu[ABT_PH(1)] << 16); ac.y = ctu[ABT_PH(2)] | (ctu[ABT_PH(3)] << 16); ac.z = ctu[ABT_PH(4)] | (ctu[ABT_PH(5)] << 16); ac.w = ctu[ABT_PH(6)] | (ctu[ABT_PH(7)] << 16);
                    as.x = stu[ABT_PH(0)] | (stu[ABT_PH(1)] << 16); as.y = stu[ABT_PH(2)] | (stu[ABT_PH(3)] << 16); as.z = stu[ABT_PH(4)] | (stu[ABT_PH(5)] << 16); as.w = stu[ABT_PH(6)] | (stu[ABT_PH(7)] << 16);
#undef ABT_PH
                    dc = __builtin_amdgcn_mfma_f32_16x16x32_bf16(__builtin_bit_cast(bf16x8, ac), __builtin_bit_cast(bf16x8, bw), dc, 0, 0, 0);
                    ds = __builtin_amdgcn_mfma_f32_16x16x32_bf16(__builtin_bit_cast(bf16x8, as), __builtin_bit_cast(bf16x8, bw), ds, 0, 0, 0); }
                bf16_t* o = abt + ((size_t)g * 512 + 2 * (ebk * 16 + i16)) * 256 + cb * 16 + 4 * kg;
                *(GAS u32x2*)o = (u32x2){pg8::cvt_pk_bf16(dc[0], dc[1]), pg8::cvt_pk_bf16(dc[2], dc[3])};
                *(GAS u32x2*)(o + 256) = (u32x2){pg8::cvt_pk_bf16(ds[0], ds[1]), pg8::cvt_pk_bf16(ds[2], ds[3])};
            }
        }
        for (int it = gw * 64 + lane; it < 256 * 512 / 8; it += NGW * 64) {
            const int k0 = (it & 63) * 8, s2p = it >> 6; float v[8];
#pragma unroll
            for (int e = 0; e < 8; ++e) { const int k = k0 + e, s2 = k >> 1; const float a2 = (float)((s2 * s2p) & 255) * (1.0f / 128.0f);
                v[e] = ((k & 1) ? sinpif(a2) : cospif(a2)) * (1.0f / 1024.0f); }
            v4u o; o.x = pk2(v[0], v[1]); o.y = pk2(v[2], v[3]); o.z = pk2(v[4], v[5]); o.w = pk2(v[6], v[7]);
            *(GAS v4u*)(trig2 + (size_t)it * 8) = o;
        }
        {
            constexpr int I_QKV = (2048 / 64) * (3072 / 32), I_U = (2048 / 64) * (1024 / 32), I_O = (2048 / 64) * (2048 / 32), I_UP = (2048 / 64) * (8192 / 32), I_D = (8192 / 64) * (2048 / 32);
            constexpr int NITEMS = I_QKV + I_U + I_O + I_UP + I_D;
            for (int it = gw; it < NITEMS; it += NGW) {
                int r = it;
                if (r < I_QKV) { p0_transpose_item(w_in, 4096, 1024, 2048, 3072, g_mix, wint, scr, r, lane); continue; } r -= I_QKV;
                if (r < I_U) { p0_transpose_item(w_in, 4096, 0, 2048, 1024, g_mix, wint + (size_t)3072 * 2048, scr, r, lane); continue; } r -= I_U;
                if (r < I_O) { p0_transpose_item_wo(w_out, wo, scr, r, lane); continue; } r -= I_O;
                if (r < I_UP) { p0_transpose_item(w_up, 8192, 0, 2048, 8192, g_mlp, wup, scr, r, lane); continue; } r -= I_UP;
                p0_transpose_item(w_down, 2048, 0, 8192, 2048, nullptr, wd, scr, r, lane);
            }
        }
    }
    xcd_barrier(bar, wave);

    {
        pg8::AddrStd g{xb, wint, 2048, 2048, 30, 0u}; pg8::StaticOrder S; S.init(T, 4096, G, (int)blockIdx.x, WGM_Q);
        pg8::EpiB<0, 1, false, true> E{qkv, 1024, inv0, nullptr, 1024, (size_t)T * 1024, QSCALE};
        pg8::gemm_phase<pg8::EpiB<0, 1, false, true>, pg8::StaticOrder, pg8::AddrStd, true>(lds, 2048, g, S, E, wave);
    }
    xcd_barrier(bar, wave);
    {
        pg8::AddrF1u g{abt, qkv + (size_t)3 * T * 1024}; pg8::StaticOrder S; S.init(2048, T, G, (int)blockIdx.x, WGM_F);
        pg8::EpiDft1 E{zt, lds};
        const int nu = (S.nwg - (int)blockIdx.x + G - 1) / G;
#pragma unroll 1
        for (int i = 0; i < nu; ++i) { pg8::OneUnit o; (void)S.next(i, o.u);
            pg8::gemm_phase<pg8::EpiDft1, pg8::OneUnit, pg8::AddrF1u, true>(lds, 256, g, o, E, wave); }
    }

    bf16_t* const part0 = (bf16_t*)out; bf16_t* const part1 = part0 + (size_t)T * 1024;
    float* const mlb0 = (float*)((unsigned char*)out + 64 * MiB); float* const mlb1 = mlb0 + (size_t)T * NH * 2;
    const int vwave = (G % 8 == 0) ? (int)(((blockIdx.x & 7) * (G >> 3) + (blockIdx.x >> 3)) * NWAVES + wave) : gw;
    {
        LAS unsigned char* wl = lds + wave * 16384;
        int lna = (int)lane_id_fresh(); asm volatile("" : "+v"(lna));
        constexpr int NU = NB * NH * 256;
#define AT_DEC_AB(U_, QP, KP, VP, TQ, DL, SL, PP, MP) do { const int pr_ = (U_) >> 8, sl_ = (U_) & 255, h_ = pr_ & 7; const size_t hb_ = (size_t)(pr_ >> 3) * SEQ * 1024 + h_ * 128; \
            const size_t hm_ = (size_t)pr_ * SEQ * 128; QP = qkv + hm_; KP = qkv + (size_t)T * 1024 + hm_ / 2; VP = qkv + (size_t)2 * T * 1024 + hm_ / 2; const float s2_ = exp2f(-(float)(h_ + 1)) * LOG2E; \
            if (sl_ < 128) { DL = 16; TQ = 512 * (sl_ >> 4) + (sl_ & 15); PP = part0 + hm_; MP = mlb0 + (size_t)pr_ * SEQ * 2; } \
            else { const int s_ = sl_ - 128; DL = 4; TQ = 128 * (s_ >> 2) + (s_ & 3); PP = part1 + hm_; MP = mlb1 + (size_t)pr_ * SEQ * 2; } SL = s2_ * (float)DL; } while (0)
        int U = vwave;
        if (U < NU) {
            const bf16_t *cq, *ck, *cv, *nq, *nk, *nv; bf16_t *cp, *np_; float *cm, *nm; int ctq, cdl, ntq = 0, ndl = 1; float csl, nsl = 0.f;
            AT_DEC_AB(U, cq, ck, cv, ctq, cdl, csl, cp, cm);
            nq = cq; nk = ck; nv = cv; np_ = cp; nm = cm;
            bf16x8 qr[8];
            at_unit_prologue(wl, qr, cq, ck, cv, ctq, cdl, lna);
#pragma unroll 1
            for (;;) {
                const int Un = U + NGW; const bool hn = Un < NU;
                if (hn) AT_DEC_AB(Un, nq, nk, nv, ntq, ndl, nsl, np_, nm);
                attn_unit(false, hn, wl, cq, ck, cv, ctq, cdl, csl, qr, nq, nk, nv, ntq, ndl, cp, cm, nullptr, nullptr, nullptr, nullptr, nullptr, lna);
                if (!hn) break;
                U = Un; cq = nq; ck = nk; cv = nv; ctq = ntq; cdl = ndl; csl = nsl; cp = np_; cm = nm;
            }
        }
#undef AT_DEC_AB
    }
    xcd_barrier(bar, wave);

    {
        LAS unsigned char* wl = lds + wave * 16384;
        int lna = (int)lane_id_fresh(); asm volatile("" : "+v"(lna));
        constexpr int NU = NB * NH * 128;
#define AT_DEC_C(U_, QP, KP, VP, TQ, SL, P0, P1, M0, M1, YP) do { const int pr_ = (U_) >> 7, h_ = pr_ & 7, b_ = pr_ >> 3; const size_t hb_ = (size_t)b_ * SEQ * 1024 + h_ * 128; \
            const size_t hm_ = (size_t)pr_ * SEQ * 128; QP = qkv + hm_; KP = qkv + (size_t)T * 1024 + hm_ / 2; VP = qkv + (size_t)2 * T * 1024 + hm_ / 2; SL = exp2f(-(float)(h_ + 1)) * LOG2E; TQ = 32 * ((U_) & 127); \
            P0 = part0 + hm_; P1 = part1 + hm_; M0 = mlb0 + (size_t)pr_ * SEQ * 2; M1 = mlb1 + (size_t)pr_ * SEQ * 2; YP = (bf16_t*)((unsigned char*)y + (size_t)b_ * SEQ * 3072 + 2048 + h_ * 128); } while (0)
        int U = vwave;
        if (U < NU) {
            const bf16_t *cq, *ck, *cv, *nq, *nk, *nv, *c0, *c1, *n0, *n1; const float *cm0, *cm1, *nm0, *nm1; bf16_t *cy, *ny; int ctq, ntq = 0; float csl, nsl = 0.f;
            AT_DEC_C(U, cq, ck, cv, ctq, csl, c0, c1, cm0, cm1, cy);
            nq = cq; nk = ck; nv = cv; n0 = c0; n1 = c1; nm0 = cm0; nm1 = cm1; ny = cy;
            bf16x8 qr[8];
            at_unit_prologue(wl, qr, cq, ck, cv, ctq, 1, lna);
#pragma unroll 1
            for (;;) {
                const int Un = U + NGW; const bool hn = Un < NU;
                if (hn) AT_DEC_C(Un, nq, nk, nv, ntq, nsl, n0, n1, nm0, nm1, ny);
                attn_unit(true, hn, wl, cq, ck, cv, ctq, 1, csl, qr, nq, nk, nv, ntq, 1, nullptr, nullptr, c0, c1, cm0, cm1, cy, lna);
                if (!hn) break;
                U = Un; cq = nq; ck = nk; cv = nv; ctq = ntq; csl = nsl; c0 = n0; c1 = n1; cm0 = nm0; cm1 = nm1; cy = ny;
            }
        }
#undef AT_DEC_C
        asm volatile("s_waitcnt vmcnt(0)" ::: "memory");
        __syncthreads();
    }

    {
        pg8::AddrF2 g{trig2, zt}; pg8::StaticOrder S; S.init(64 * 256, 1024, G, (int)blockIdx.x);
        pg8::EpiY E{y, 1536};
        pg8::gemm_phase<pg8::EpiY, pg8::StaticOrder, pg8::AddrF2, true>(lds, 512, g, S, E, wave);
    }
    xcd_barrier(bar, wave);

    {
        pg8::AddrStd g{y, wo, 1536, 1536, 30, 0u}; pg8::StaticOrder S; S.init(T, 2048, G, (int)blockIdx.x, WGM_O);
        pg8::EpiResXb E{xb, h1b, ssq1, 2048, 1.0f / 32.0f};
        pg8::gemm_phase<pg8::EpiResXb, pg8::StaticOrder, pg8::AddrStd, true, 16>(lds, 1536, g, S, E, wave);
    }
    xcd_barrier(bar, wave);

    const bool fuse7 = G >= (T / 2 / 256) * (DM / 256);
    for (int half = 0; half < 2; ++half) {
        const size_t roff = (size_t)half * (T / 2);
        bf16_t* const ab = (fuse7 && half) ? (bf16_t*)(ws + WS_XB) : abuf;
        {
            pg8::AddrStd g{h1b + roff * DM, wup, 2048, 2048, 30, 0u}; pg8::StaticOrder S; S.init(T / 2, DFF, G, (int)blockIdx.x, WGM_U);
            pg8::EpiB<2, 2, false> E{ab, DFF, ssq1 + roff, nullptr, 0, 0, 1.f};
            pg8::gemm_phase<pg8::EpiB<2, 2, false>, pg8::StaticOrder, pg8::AddrStd, true>(lds, 2048, g, S, E, wave);
        }
        xcd_barrier(bar, wave);
        if (fuse7) {
            pg8::AddrStd g{ab, wd, DFF, DFF, 30, 0u}; pg8::StaticOrder S; S.init(T / 2, 2048, G, (int)blockIdx.x, WGM_D);
            pg8::EpiResOut E{h1b + roff * DM, (unsigned long long*)(ws + WS_SSQX) + roff, out + roff * DM, g_fin, (unsigned*)(ws + WS_CTL) + CW_BAR + XB_TMO, 2048, 32u};
            pg8::gemm_phase<pg8::EpiResOut, pg8::StaticOrder, pg8::AddrStd, true>(lds, DFF, g, S, E, wave);
        } else {
            pg8::AddrStd g{abuf, wd, DFF, DFF, 30, 0u}; pg8::StaticOrder S; S.init(T / 2, 2048, G, (int)blockIdx.x, WGM_D);
            pg8::EpiResB E{h1b + roff * DM, ssq2 + roff, 2048};
            pg8::gemm_phase<pg8::EpiResB, pg8::StaticOrder, pg8::AddrStd, true>(lds, DFF, g, S, E, wave);
            xcd_barrier(bar, wave);
        }
    }
    if (fuse7) return;

    const int lane7 = (int)lane_id_fresh();
    for (int m = gw; m < T; m += NGW) {
        const GAS v4u* hr = (const GAS v4u*)(h1b + (size_t)m * DM) + lane7; GAS f32x4* xr = (GAS f32x4*)(out + (size_t)m * DM) + 2 * lane7; const GAS f32x4* gr = (const GAS f32x4*)g_fin + 2 * lane7;
        const float inv = 1.0f / sqrtf(ssq2[m] * (1.0f / DM) + EPS);
#pragma unroll
        for (int j = 0; j < 4; ++j) { const v4u b = __builtin_nontemporal_load(&hr[64 * j]); const f32x4 g0 = gr[128 * j], g1 = gr[128 * j + 1];
            __builtin_nontemporal_store((f32x4){bf2f(b.x & 0xffffu) * inv * g0.x, bf2f(b.x >> 16) * inv * g0.y, bf2f(b.y & 0xffffu) * inv * g0.z, bf2f(b.y >> 16) * inv * g0.w}, &xr[128 * j]);
            __builtin_nontemporal_store((f32x4){bf2f(b.z & 0xffffu) * inv * g1.x, bf2f(b.z >> 16) * inv * g1.y, bf2f(b.w & 0xffffu) * inv * g1.z, bf2f(b.w >> 16) * inv * g1.w}, &xr[128 * j + 1]); }
    }
}

extern "C" void kernel_launch(void* const* d_in, const int* in_sizes, int n_in, void* d_out, int out_size, void* d_ws, size_t ws_size, hipStream_t stream) {
    static int grid = 0;
    if (grid == 0) {
        if (n_in != 9 || in_sizes[0] != T * DM || out_size != T * DM || ws_size < WS_END) {
            fprintf(stderr, "kernel_launch: unexpected shapes: n_in %d in0 %d out %d ws %zu (need >= %zu)\n", n_in, n_in > 0 ? in_sizes[0] : -1, out_size, ws_size, (size_t)WS_END);
            grid = -1; return; }
        int dev = 0, cus = 0, per_cu = 0;
        if (hipGetDevice(&dev) != hipSuccess || hipDeviceGetAttribute(&cus, hipDeviceAttributeMultiprocessorCount, dev) != hipSuccess) { fprintf(stderr, "kernel_launch: device query failed\n"); grid = -1; return; }
        if (hipFuncSetAttribute((const void*)mk_fwd, hipFuncAttributeMaxDynamicSharedMemorySize, LDS_BYTES) != hipSuccess) { fprintf(stderr, "kernel_launch: hipFuncSetAttribute failed\n"); grid = -1; return; }
        if (hipOccupancyMaxActiveBlocksPerMultiprocessor(&per_cu, (const void*)mk_fwd, NWAVES * 64, LDS_BYTES) != hipSuccess || per_cu < 1) {
            fprintf(stderr, "kernel_launch: occupancy query reports %d workgroups per CU; need 1\n", per_cu); (void)hipGetLastError(); grid = -1; return; }
        grid = cus;
    }
    if (grid < 0) return;
    if (hipMemsetAsync((char*)d_ws + WS_CTL, 0, CTL_ZERO_BYTES, stream) != hipSuccess) { fprintf(stderr, "kernel_launch: hipMemsetAsync failed\n"); return; }
    Args a{};
    for (int i = 0; i < 9; ++i) a.in[i] = (const float*)d_in[i];
    a.out = (float*)d_out; a.ws = (unsigned char*)d_ws;
    hipLaunchKernelGGL(mk_fwd, dim3(grid), dim3(NWAVES * 64), LDS_BYTES, stream, a);
    const hipError_t le = hipPeekAtLastError();
    if (le != hipSuccess) fprintf(stderr, "kernel_launch: launch failed: %s\n", hipGetErrorName(le));
}
```
